# Optimizing an MI355X kernel written in HIP

```python
import math
import jax, jax.numpy as jnp
from jax import lax
import numpy as np

D_MODEL = 2048
BATCH = 2
SEQ = 8192
DEPTH = 2

MIX_W = D_MODEL // 2
N_BRANCH = 3
RET_HEADS = 8
RET_DK = MIX_W // RET_HEADS
RET_DV = MIX_W // RET_HEADS
RET_CHUNK = 128
RET_ROPE_BASE = 10000.0
CONV_CH = MIX_W
CONV_GROUPS = 8
CONV_K = 3
ATT_HEADS = 8
ATT_DH = MIX_W // ATT_HEADS
IDX_HEADS = 8
IDX_DH = 64
TOPK_MAX = 256
ATT_BLOCK = 128
REL_BUCKETS = 32
REL_MAX_DIST = 128
D_FF = 5632
N_EXPERTS = 8
TOP_K = 2
D_FF_EXPERT = 7168
EPS = 1e-6

N_DENSE = (DEPTH + 1) // 2
N_MOE = DEPTH // 2
IN_SPLITS = (RET_HEADS * RET_DK, RET_HEADS * RET_DK, RET_HEADS * RET_DV, RET_HEADS * RET_DV,
             CONV_CH, CONV_CH, CONV_CH,
             ATT_HEADS * ATT_DH, ATT_HEADS * ATT_DH, ATT_HEADS * ATT_DH,
             IDX_HEADS * IDX_DH, IDX_DH, IDX_HEADS,
             N_BRANCH * D_MODEL)
IN_COLS = sum(IN_SPLITS)

kernel_name = "hybrid_retention_shortconv_dsa_moe"


def rmsnorm(x, g):
    xf = x.astype(jnp.float32)
    y = xf * lax.rsqrt(jnp.mean(xf * xf, axis=-1, keepdims=True) + EPS)
    return (y * g.astype(jnp.float32)).astype(x.dtype)


def rotary(x, positions):
    d = x.shape[-1]
    inv_freq = RET_ROPE_BASE ** (-jnp.arange(0, d, 2, dtype=jnp.float32) / d)
    ang = positions.astype(jnp.float32)[..., None] * inv_freq
    cos = jnp.cos(ang)[:, :, None, :]
    sin = jnp.sin(ang)[:, :, None, :]
    xf = x.astype(jnp.float32)
    x1, x2 = xf[..., : d // 2], xf[..., d // 2:]
    return jnp.concatenate([x1 * cos - x2 * sin, x1 * sin + x2 * cos], axis=-1).astype(x.dtype)


def retention(q, k, v):
    B, S, H, dk = q.shape
    dv = v.shape[-1]
    C = RET_CHUNK
    N = S // C
    log_g = jnp.log1p(-jnp.exp2(-5.0 - jnp.arange(H, dtype=jnp.float32)))
    pos = jnp.arange(C, dtype=jnp.float32)
    diff = pos[:, None] - pos[None, :]
    intra_decay = jnp.where(diff >= 0, jnp.exp(jnp.maximum(diff, 0.0)[None] * log_g[:, None, None]),
                            0.0).astype(q.dtype)
    k_decay = jnp.exp((C - 1 - pos)[:, None] * log_g[None, :]).astype(q.dtype)
    q_decay = jnp.exp((pos + 1)[:, None] * log_g[None, :]).astype(q.dtype)
    chunk_decay = jnp.exp(C * log_g).astype(q.dtype)
    qc = q.reshape(B, N, C, H, dk)
    kc = (k * dk ** -0.5).reshape(B, N, C, H, dk)
    vc = v.reshape(B, N, C, H, dv)
    scores = jnp.einsum('bnihd,bnjhd->bnhij', qc, kc) * intra_decay
    intra = jnp.einsum('bnhij,bnjhe->bnihe', scores, vc)
    kv = jnp.einsum('bnjhd,jh,bnjhe->nbhde', kc, k_decay, vc)

    def step(state, kv_n):
        return state * chunk_decay[:, None, None] + kv_n, state

    _, prev = lax.scan(step, jnp.zeros((B, H, dk, dv), kv.dtype), kv)
    cross = jnp.einsum('bnihd,nbhde->bnihe', qc, prev) * q_decay[:, :, None]
    return (intra + cross).reshape(B, S, H, dv)


def head_groupnorm(y, w, b):
    B, S, H, dv = y.shape
    yf = y.astype(jnp.float32)
    mu = jnp.mean(yf, axis=-1, keepdims=True)
    var = jnp.mean(jnp.square(yf - mu), axis=-1, keepdims=True)
    out = ((yf - mu) * lax.rsqrt(var + EPS)).reshape(B, S, H * dv)
    return (out * w.astype(jnp.float32) + b.astype(jnp.float32)).astype(y.dtype)


def short_gated_conv(b_gate, c_gate, u_in, conv_w):
    u = c_gate * u_in
    conv = lax.conv_general_dilated(u, conv_w[:, None, :].astype(u.dtype), window_strides=(1,),
                                    padding=[(CONV_K - 1, 0)],
                                    dimension_numbers=('NWC', 'WIO', 'NWC'),
                                    feature_group_count=CONV_CH)
    return b_gate * conv


def head_rms(x, g):
    xf = x.astype(jnp.float32)
    y = xf * lax.rsqrt(jnp.mean(xf * xf, axis=-1, keepdims=True) + EPS)
    return (y * g.astype(jnp.float32)).astype(x.dtype)


def t5_bucket(rel):
    n = jnp.maximum(rel, 0)
    max_exact = REL_BUCKETS // 2
    nf = jnp.maximum(n, 1).astype(jnp.float32)
    large = max_exact + (jnp.log(nf / max_exact) / math.log(REL_MAX_DIST / max_exact)
                         * (REL_BUCKETS - max_exact)).astype(jnp.int32)
    large = jnp.minimum(large, REL_BUCKETS - 1)
    return jnp.where(n < max_exact, n, large)


def dsa_attention(q, k, v, qi, ki, wi, positions, rel_bias):
    B, S, H, dh = q.shape
    k_sel = min(TOPK_MAX, S // 4)
    nb = S // ATT_BLOCK

    def blocks(a):
        return a.reshape((B, nb, ATT_BLOCK) + a.shape[2:]).swapaxes(0, 1)

    starts = jnp.arange(nb, dtype=jnp.int32) * ATT_BLOCK
    key_idx = jnp.arange(S, dtype=jnp.int32)
    gather = jax.vmap(lambda table, idx: table[idx])

    def one_block(args):
        q_b, qi_b, w_b, pos_b, start = args
        t_idx = start + jnp.arange(ATT_BLOCK, dtype=jnp.int32)
        dots = jnp.einsum('bthd,bsd->bths', qi_b, ki)
        score = jnp.einsum('bth,bths->bts', w_b, jax.nn.relu(dots)).astype(jnp.float32)
        causal = key_idx[None, :] <= t_idx[:, None]
        score = jnp.where(causal[None], score, -jnp.inf)
        _, idx = lax.top_k(score, k_sel)
        k_g = gather(k, idx)
        v_g = gather(v, idx)
        p_g = gather(positions, idx)
        bias = rel_bias[t5_bucket(pos_b[:, :, None] - p_g)]
        logits = (jnp.einsum('bthd,btkhd->bhtk', q_b, k_g).astype(jnp.float32) * dh ** -0.5
                  + bias.astype(jnp.float32).transpose(0, 3, 1, 2))
        valid = idx <= t_idx[None, :, None]
        logits = jnp.where(valid[:, None], logits, -jnp.inf)
        p = jax.nn.softmax(logits, axis=-1).astype(v.dtype)
        return jnp.einsum('bhtk,btkhd->bthd', p, v_g)

    out = lax.map(one_block, (blocks(q), blocks(qi), blocks(wi), blocks(positions), starts))
    return out.swapaxes(0, 1).reshape(B, S, H * dh)


def mixer(h, positions, rel_bias, w_in, w_br, w_o, ret_gn_w, ret_gn_b, conv_w, q_norm, k_norm):
    B, S, _ = h.shape
    points = [int(p) for p in np.cumsum(IN_SPLITS)[:-1]]
    (rq, rk, rv, rg, cb, cc, cu, aq, ak, av, iq, ik, iw, gates) = jnp.split(h @ w_in, points, axis=-1)
    rq = rotary(rq.reshape(B, S, RET_HEADS, RET_DK), positions)
    rk = rotary(rk.reshape(B, S, RET_HEADS, RET_DK), positions)
    ret = retention(rq, rk, rv.reshape(B, S, RET_HEADS, RET_DV))
    y_ret = jax.nn.silu(rg) * head_groupnorm(ret, ret_gn_w, ret_gn_b)
    y_conv = short_gated_conv(cb, cc, cu, conv_w)
    q = head_rms(aq.reshape(B, S, ATT_HEADS, ATT_DH), q_norm)
    k = head_rms(ak.reshape(B, S, ATT_HEADS, ATT_DH), k_norm)
    v = av.reshape(B, S, ATT_HEADS, ATT_DH)
    qi = iq.reshape(B, S, IDX_HEADS, IDX_DH) * IDX_DH ** -0.5
    wi = iw * IDX_HEADS ** -0.5
    y_att = dsa_attention(q, k, v, qi, ik, wi, positions, rel_bias)
    y = jnp.stack([y_ret.astype(h.dtype), y_conv.astype(h.dtype), y_att.astype(h.dtype)], axis=0)
    branch = jnp.einsum('nbsc,ncd->nbsd', y, w_br)
    g = jax.nn.sigmoid(gates.reshape(B, S, N_BRANCH, D_MODEL))
    merged = jnp.einsum('bsnd,nbsd->bsd', g, branch)
    return merged @ w_o


def swiglu(h, w1, w3, w2):
    return (jax.nn.silu(h @ w1) * (h @ w3)) @ w2


def moe(h, router, w1, w3, w2):
    logits = (h @ router).astype(jnp.float32)
    top_vals, top_idx = lax.top_k(logits, TOP_K)
    top_w = jax.nn.softmax(top_vals, axis=-1)
    combine = jnp.einsum('bske,bsk->bse', jax.nn.one_hot(top_idx, N_EXPERTS, dtype=jnp.float32), top_w)
    out = jnp.zeros_like(h)
    for e in range(N_EXPERTS):
        out = out + combine[..., e:e + 1].astype(h.dtype) * swiglu(h, w1[e], w3[e], w2[e])
    return out


def setup_inputs(seed: int = 0) -> dict:
    key = jax.random.key(seed)
    ks = jax.random.split(key, 20)
    f32 = jnp.float32
    nrm = lambda k, shape, s: jax.random.normal(k, shape, f32) * s
    return {
        "x": nrm(ks[0], (BATCH, SEQ, D_MODEL), 1.0),
        "positions": jnp.broadcast_to(jnp.arange(SEQ, dtype=jnp.int32), (BATCH, SEQ)),
        "rel_bias": nrm(ks[1], (REL_BUCKETS, ATT_HEADS), 0.5),
        "norm_mix": 1.0 + nrm(ks[2], (DEPTH, D_MODEL), 0.02),
        "norm_ffn": 1.0 + nrm(ks[3], (DEPTH, D_MODEL), 0.02),
        "w_in": nrm(ks[4], (DEPTH, D_MODEL, IN_COLS), D_MODEL ** -0.5),
        "w_br": nrm(ks[5], (DEPTH, N_BRANCH, MIX_W, D_MODEL), MIX_W ** -0.5),
        "w_o": nrm(ks[6], (DEPTH, D_MODEL, D_MODEL), D_MODEL ** -0.5),
        "ret_gn_w": 1.0 + nrm(ks[7], (DEPTH, MIX_W), 0.02),
        "ret_gn_b": nrm(ks[8], (DEPTH, MIX_W), 0.02),
        "conv_w": nrm(ks[9], (DEPTH, CONV_K, CONV_CH), CONV_K ** -0.5),
        "q_norm": 1.0 + nrm(ks[10], (DEPTH, ATT_DH), 0.02),
        "k_norm": 1.0 + nrm(ks[11], (DEPTH, ATT_DH), 0.02),
        "ffn_w1": nrm(ks[12], (N_DENSE, D_MODEL, D_FF), D_MODEL ** -0.5),
        "ffn_w3": nrm(ks[13], (N_DENSE, D_MODEL, D_FF), D_MODEL ** -0.5),
        "ffn_w2": nrm(ks[14], (N_DENSE, D_FF, D_MODEL), D_FF ** -0.5),
        "moe_router": nrm(ks[15], (N_MOE, D_MODEL, N_EXPERTS), D_MODEL ** -0.5),
        "moe_w1": nrm(ks[16], (N_MOE, N_EXPERTS, D_MODEL, D_FF_EXPERT), D_MODEL ** -0.5),
        "moe_w3": nrm(ks[17], (N_MOE, N_EXPERTS, D_MODEL, D_FF_EXPERT), D_MODEL ** -0.5),
        "moe_w2": nrm(ks[18], (N_MOE, N_EXPERTS, D_FF_EXPERT, D_MODEL), D_FF_EXPERT ** -0.5),
    }


def reference(x, positions, rel_bias, norm_mix, norm_ffn, w_in, w_br, w_o, ret_gn_w, ret_gn_b,
              conv_w, q_norm, k_norm, ffn_w1, ffn_w3, ffn_w2, moe_router, moe_w1, moe_w3, moe_w2):
    for l in range(DEPTH):
        h = rmsnorm(x, norm_mix[l])
        x = x + mixer(h, positions, rel_bias, w_in[l], w_br[l], w_o[l], ret_gn_w[l], ret_gn_b[l],
                      conv_w[l], q_norm[l], k_norm[l])
        h = rmsnorm(x, norm_ffn[l])
        if l % 2 == 0:
            d = l // 2
            x = x + swiglu(h, ffn_w1[d], ffn_w3[d], ffn_w2[d])
        else:
            m = l // 2
            x = x + moe(h, moe_router[m], moe_w1[m], moe_w3[m], moe_w2[m])
    return x
```

```cpp
#include <hip/hip_runtime.h>
#include <cstdio>
#include <cstdint>

#define GAS __attribute__((address_space(1)))
#define LAS __attribute__((address_space(3)))
namespace pg8 {
#define PG8_LAS __attribute__((address_space(3)))
typedef unsigned short bf16_t;
typedef short bf16x8 __attribute__((ext_vector_type(8)));
typedef float f32x4 __attribute__((ext_vector_type(4)));
typedef unsigned u32x4 __attribute__((ext_vector_type(4)));
constexpr int BM = 256, BK = 64, HALF = 128, HTB = HALF * BK * 2  , STAGE_BYTES = 8 * HTB, NXCD = 8, WGM = 8;

__host__ __device__ __forceinline__ int lds_byte(int r, int c) { const int st = (r >> 4) * 2 + (c >> 5), rr = r & 15, cc = c & 31, ob = rr * 64 + cc * 2; return st * 1024 + (ob ^ (((ob >> 9) & 1) << 5)); }
__host__ __device__ __forceinline__ void stage_rc(int b, int& R, int& C) { const int st = b / 1024, sb = b % 1024, swz = sb ^ (((sb >> 9) & 1) << 5); R = (st >> 1) * 16 + swz / 64; C = (st & 1) * 32 + (swz % 64) / 2; }
__host__ __device__ __forceinline__ int perm32(int rho) { const int n = rho >> 4, i = rho & 15; return 8 * (i >> 2) + 4 * n + (i & 3); }

struct Unit { int pm, pn, koff, nt, z; };
struct Gemm { const bf16_t* A; const bf16_t* Bt; int M, N, K, lda, ldb; };

struct StaticOrder {
    int nM, nN, nwg, G, c;
    __host__ __device__ void init(int M, int N, int G_, int c_) { nM = M / BM; nN = N / BM; nwg = nM * nN; G = G_; c = c_; }
    __host__ __device__ bool next(int i, Unit& u) const {
        const long L = (long)i * G + c; if (L >= nwg) return false;
        int wgid = (int)L; { const int q = nwg / NXCD, r = nwg % NXCD, xcd = wgid % NXCD, off = wgid / NXCD; wgid = (xcd < r ? xcd * (q + 1) : r * (q + 1) + (xcd - r) * q) + off; }
        const int nig = WGM * nN, gid = wgid / nig, fm = gid * WGM, gsz = (nM - fm) < WGM ? (nM - fm) : WGM;
        u.pm = fm + ((wgid % nig) % gsz); u.pn = (wgid % nig) / gsz; u.koff = 0; u.nt = 0; u.z = 0; return true;
    }
    __device__ __forceinline__ void a_ready(const Unit&) const {}
    __device__ __forceinline__ void done(const Unit&) const {}
};

typedef float f32x2_t __attribute__((ext_vector_type(2)));
typedef __bf16 bf16x2_t __attribute__((ext_vector_type(2)));
__device__ __forceinline__ unsigned cvt_pk_bf16(float lo, float hi) { f32x2_t v = {lo, hi}; bf16x2_t b = __builtin_convertvector(v, bf16x2_t); return __builtin_bit_cast(unsigned, b); }
__device__ __forceinline__ unsigned cvt_pk4_fp8(float a, float b, float c, float d) { int r = __builtin_amdgcn_cvt_pk_fp8_f32(a, b, 0, false); r = __builtin_amdgcn_cvt_pk_fp8_f32(c, d, r, true); return (unsigned)r; }
constexpr float F8_WSCALE = 64.f, F8_ASCALE = 4.f;

typedef PG8_LAS float PG8_LASF;
typedef int i32x4_t __attribute__((ext_vector_type(4)));
typedef int i32x8_t __attribute__((ext_vector_type(8)));
__device__ __forceinline__ i32x8_t cat8(bf16x8 a, bf16x8 b) { return __builtin_shufflevector(__builtin_bit_cast(i32x4_t, a), __builtin_bit_cast(i32x4_t, b), 0, 1, 2, 3, 4, 5, 6, 7); }
template <class Epi, class Sched, bool ALIGN_EPI = false, bool SP2 = false, bool FP8 = false>
__device__ __forceinline__ void gemm_phase(PG8_LAS unsigned char* lds, const Gemm g, const Sched& S, const Epi& E, const int tid_in) {
    const int tid = tid_in, wid = __builtin_amdgcn_readfirstlane(tid >> 6), lane = tid & 63, wr = wid >> 2, wc = wid & 3, fr = lane & 15, fq = lane >> 4;
    const int ntf = g.K / BK; int nt;
    unsigned voffA[2], voffB[2];
#pragma unroll
    for (int i = 0; i < 2; ++i) { int R, C; stage_rc(tid * 16 + i * 8192, R, C); const int Rb = Epi::PERM ? ((R & ~31) + perm32(R & 31)) : R;
        voffA[i] = (unsigned)(R * g.lda + C) * 2u; voffB[i] = (unsigned)(Rb * g.ldb + C) * 2u; }
    const size_t kstep = (size_t)(BK * 2);
    const size_t hstepB = (size_t)HALF * g.ldb * 2, hstepA = (size_t)HALF * g.lda * 2;
    const size_t tstepA = 2 * hstepA, tstepB = 2 * hstepB;
    const unsigned ldsw = (unsigned)wid * 1024u;
    const int aoff = lds_byte(wr * 64 + fr, fq * 8), boff = lds_byte(wc * 32 + fr, fq * 8);
#define PG8_SA(b, h) (((b) * 2 + (h)) * HTB)
#define PG8_SB(b, h) ((4 + (b) * 2 + (h)) * HTB)
#define PG8_STAGE(bufoff, gbase, voff) do { _Pragma("unroll") for (int _i = 0; _i < 2; ++_i) \
        __builtin_amdgcn_global_load_lds((const unsigned*)((const char*)(gbase) + (voff)[_i]), (PG8_LAS unsigned*)(lds + (bufoff) + ldsw + _i * 8192), 16, 0, 0); } while (0)
#define PG8_LDA(dst, b, h) do { if constexpr (FP8) { _Pragma("unroll") for (int m = 0; m < 4; ++m) dst##8[m] = cat8(*(const PG8_LAS bf16x8*)(lds + PG8_SA(b, h) + aoff + m * 2048), *(const PG8_LAS bf16x8*)(lds + PG8_SA(b, h) + aoff + m * 2048 + 1024)); } \
        else { _Pragma("unroll") for (int m = 0; m < 4; ++m) _Pragma("unroll") for (int k = 0; k < 2; ++k) dst[m][k] = *(const PG8_LAS bf16x8*)(lds + PG8_SA(b, h) + aoff + m * 2048 + k * 1024); } } while (0)
#define PG8_LDB(dst, b, h) do { if constexpr (FP8) { _Pragma("unroll") for (int n = 0; n < 2; ++n) dst##8[n] = cat8(*(const PG8_LAS bf16x8*)(lds + PG8_SB(b, h) + boff + n * 2048), *(const PG8_LAS bf16x8*)(lds + PG8_SB(b, h) + boff + n * 2048 + 1024)); } \
        else { _Pragma("unroll") for (int n = 0; n < 2; ++n) _Pragma("unroll") for (int k = 0; k < 2; ++k) dst[n][k] = *(const PG8_LAS bf16x8*)(lds + PG8_SB(b, h) + boff + n * 2048 + k * 1024); } } while (0)
#define PG8_MMA(ai, bj, At, Bt) do { __builtin_amdgcn_s_setprio(1); if constexpr (FP8) { _Pragma("unroll") for (int m = 0; m < 4; ++m) _Pragma("unroll") for (int n = 0; n < 2; ++n) \
        asm volatile("v_mfma_scale_f32_16x16x128_f8f6f4 %0, %1, %2, %0, %3, %3 op_sel_hi:[0,0,0]" : "+v"(acc[ai][bj][m][n]) : "v"(Bt##8[n]), "v"(At##8[m]), "v"(f8scale)); } \
        else { _Pragma("unroll") for (int m = 0; m < 4; ++m) _Pragma("unroll") for (int n = 0; n < 2; ++n) _Pragma("unroll") for (int k = 0; k < 2; ++k) \
        acc[ai][bj][m][n] = __builtin_amdgcn_mfma_f32_16x16x32_bf16(Bt[n][k], At[m][k], acc[ai][bj][m][n], 0, 0, 0); } __builtin_amdgcn_s_setprio(0); } while (0)
#define PG8_WAIT_V(n) asm volatile("s_waitcnt vmcnt(" #n ")" ::: "memory")
#define PG8_WAIT_L(n) asm volatile("s_waitcnt lgkmcnt(" #n ")" ::: "memory")
#define PG8_BAR __builtin_amdgcn_s_barrier()
#define PG8_SCHED __builtin_amdgcn_sched_barrier(0)
    Unit cur, nxt; int ui = 0;
    if (!S.next(0, cur)) return;
    const int f8scale = 0x7F7F7F7F;
    f32x4 acc[2][2][4][2];
#pragma unroll
    for (int a = 0; a < 2; ++a)
#pragma unroll
        for (int b = 0; b < 2; ++b)
#pragma unroll
            for (int m = 0; m < 4; ++m)
#pragma unroll
                for (int n = 0; n < 2; ++n) acc[a][b][m][n] = (f32x4){0.f, 0.f, 0.f, 0.f};
    bf16x8 At[4][2], B0[2][2], B1[2][2]; i32x8_t At8[4], B08[2], B18[2];
    const char* cA = (const char*)g.A + (size_t)cur.pm * tstepA + (size_t)cur.koff * 2; const char* cB = (const char*)g.Bt + (size_t)cur.pn * tstepB + (size_t)cur.koff * 2; nt = cur.nt ? cur.nt : ntf;
    S.a_ready(cur);
    if constexpr (SP2) {
        PG8_STAGE(PG8_SB(0, 0), cB, voffB); PG8_STAGE(PG8_SB(0, 1), cB + hstepB, voffB); PG8_STAGE(PG8_SA(0, 0), cA, voffA); PG8_STAGE(PG8_SA(0, 1), cA + hstepA, voffA);
        if (wr == 1) PG8_BAR;
        PG8_WAIT_V(2); PG8_BAR;
        PG8_STAGE(PG8_SB(1, 0), cB + kstep, voffB); PG8_STAGE(PG8_SA(1, 0), cA + kstep, voffA); PG8_STAGE(PG8_SB(1, 1), cB + hstepB + kstep, voffB);
        PG8_WAIT_V(6); PG8_BAR;
    } else {
        PG8_STAGE(PG8_SB(0, 0), cB, voffB); PG8_STAGE(PG8_SA(0, 0), cA, voffA); PG8_STAGE(PG8_SB(0, 1), cB + hstepB, voffB); PG8_STAGE(PG8_SA(0, 1), cA + hstepA, voffA);
        if (wr == 1) PG8_BAR;
        PG8_WAIT_V(4); PG8_BAR;
        PG8_STAGE(PG8_SB(1, 0), cB + kstep, voffB); PG8_STAGE(PG8_SA(1, 0), cA + kstep, voffA); PG8_STAGE(PG8_SB(1, 1), cB + hstepB + kstep, voffB);
        PG8_WAIT_V(6); PG8_BAR;
    }
    for (;;) {
        const bool has_next = S.next(ui + 1, nxt);
        const char* nA = has_next ? (const char*)g.A + (size_t)nxt.pm * tstepA + (size_t)nxt.koff * 2 : cA; const char* nB = has_next ? (const char*)g.Bt + (size_t)nxt.pn * tstepB + (size_t)nxt.koff * 2 : cB;
        for (int t = 0; t < nt; t += 2) {
            if constexpr (Epi::MIDK > 0) { if (t > 0 && (t % Epi::MIDK) == 0) E.mid(acc, cur, wr, wc, fr, fq, t / Epi::MIDK); }
            const bool last = (t == nt - 2);
            const char* a1 = cA + (size_t)(t + 1) * kstep;
            const char* a2 = last ? nA : cA + (size_t)(t + 2) * kstep; const char* b2 = last ? nB : cB + (size_t)(t + 2) * kstep;
            const char* a3 = a2 + kstep; const char* b3 = b2 + kstep;
            if (last && has_next) S.a_ready(nxt);
            if constexpr (SP2) {
            PG8_LDB(B0, 0, 0); PG8_LDB(B1, 0, 1); PG8_SCHED; PG8_LDA(At, 0, 0); PG8_STAGE(PG8_SA(1, 1), a1 + hstepA, voffA);
            PG8_WAIT_V(8); PG8_WAIT_L(0); PG8_BAR; PG8_MMA(0, 0, At, B0); PG8_MMA(0, 1, At, B1); PG8_BAR; PG8_SCHED;
            PG8_LDA(At, 0, 1); PG8_STAGE(PG8_SB(0, 0), b2, voffB); PG8_STAGE(PG8_SB(0, 1), b2 + hstepB, voffB); PG8_STAGE(PG8_SA(0, 0), a2, voffA);
            PG8_WAIT_V(8); PG8_WAIT_L(0); PG8_BAR; PG8_MMA(1, 0, At, B0); PG8_MMA(1, 1, At, B1); PG8_BAR; PG8_SCHED;
            PG8_LDB(B0, 1, 0); PG8_LDB(B1, 1, 1); PG8_SCHED; PG8_LDA(At, 1, 0); PG8_STAGE(PG8_SA(0, 1), a2 + hstepA, voffA);
            PG8_WAIT_V(8); PG8_WAIT_L(0); PG8_BAR; PG8_MMA(0, 0, At, B0); PG8_MMA(0, 1, At, B1); PG8_BAR; PG8_SCHED;
            PG8_LDA(At, 1, 1); PG8_STAGE(PG8_SB(1, 0), b3, voffB); PG8_STAGE(PG8_SB(1, 1), b3 + hstepB, voffB); PG8_STAGE(PG8_SA(1, 0), a3, voffA);
            PG8_WAIT_V(8); PG8_WAIT_L(0); PG8_BAR; PG8_MMA(1, 0, At, B0); PG8_MMA(1, 1, At, B1); PG8_BAR; PG8_SCHED;
            } else {
            PG8_LDB(B0, 0, 0); PG8_SCHED; PG8_LDA(At, 0, 0); PG8_STAGE(PG8_SA(1, 1), a1 + hstepA, voffA);
            PG8_WAIT_L(8); PG8_BAR; PG8_WAIT_L(0); PG8_MMA(0, 0, At, B0); PG8_BAR; PG8_SCHED;
            PG8_LDB(B1, 0, 1); PG8_STAGE(PG8_SB(0, 0), b2, voffB);
            PG8_BAR; PG8_WAIT_L(0); PG8_MMA(0, 1, At, B1); PG8_BAR;
            PG8_LDA(At, 0, 1); PG8_STAGE(PG8_SA(0, 0), a2, voffA);
            PG8_BAR; PG8_WAIT_L(0); PG8_MMA(1, 0, At, B0); PG8_BAR; PG8_SCHED;
            PG8_STAGE(PG8_SB(0, 1), b2 + hstepB, voffB);
            PG8_WAIT_V(6); PG8_BAR; PG8_MMA(1, 1, At, B1); PG8_BAR;
            PG8_LDB(B0, 1, 0); PG8_SCHED; PG8_LDA(At, 1, 0); PG8_STAGE(PG8_SA(0, 1), a2 + hstepA, voffA);
            PG8_WAIT_L(8); PG8_BAR; PG8_WAIT_L(0); PG8_MMA(0, 0, At, B0); PG8_BAR; PG8_SCHED;
            PG8_LDB(B1, 1, 1); PG8_STAGE(PG8_SB(1, 0), b3, voffB);
            PG8_BAR; PG8_WAIT_L(0); PG8_MMA(0, 1, At, B1); PG8_BAR;
            PG8_LDA(At, 1, 1); PG8_STAGE(PG8_SA(1, 0), a3, voffA);
            PG8_BAR; PG8_WAIT_L(0); PG8_MMA(1, 0, At, B0); PG8_BAR; PG8_SCHED;
            PG8_STAGE(PG8_SB(1, 1), b3 + hstepB, voffB);
            PG8_WAIT_V(6); PG8_BAR; PG8_MMA(1, 1, At, B1); PG8_BAR;
            }
        }
        if constexpr (FP8) { asm volatile("s_nop 15\n\ts_nop 15"); PG8_SCHED; }
        if constexpr (ALIGN_EPI) { if (wr == 0) PG8_BAR; }
        if constexpr (!Epi::AFTER_DRAIN) { E(acc, cur, wr, wc, fr, fq); S.done(cur); }
        if (!has_next) break;
#pragma unroll
        for (int a = 0; a < 2; ++a)
#pragma unroll
            for (int b = 0; b < 2; ++b)
#pragma unroll
                for (int m = 0; m < 4; ++m)
#pragma unroll
                    for (int n = 0; n < 2; ++n) acc[a][b][m][n] = (f32x4){0.f, 0.f, 0.f, 0.f};
        cur = nxt; cA = nA; cB = nB; ++ui; nt = cur.nt ? cur.nt : ntf;
        if constexpr (ALIGN_EPI) { if (wr == 1) PG8_BAR; }
    }
    PG8_WAIT_V(0);
    if constexpr (!ALIGN_EPI) { if (wr == 0) PG8_BAR; }
    PG8_BAR;
    if constexpr (Epi::AFTER_DRAIN) { E.fused(acc, cur, wr, wc, fr, fq, lds, wid, lane); S.done(cur); }
#undef PG8_SA
#undef PG8_SB
#undef PG8_STAGE
#undef PG8_LDA
#undef PG8_LDB
#undef PG8_MMA
#undef PG8_WAIT_V
#undef PG8_WAIT_L
#undef PG8_BAR
#undef PG8_SCHED
}
}
#define XB_TMO      128
#define XB_XCNT(j)  (256  + 64 * (j))
#define XB_XSUB(j)  (1280 + 64 * (j))
#define XB_XGEN(j)  (2304 + 64 * (j))
#define XB_TOP      3328
#define XB_TOPGEN   3392
#define XCD_BAR_WORDS 3456
#define XB_SPIN_CAP (1u << 18)

__device__ __forceinline__ unsigned xb_ld(unsigned* p)              { return __hip_atomic_load(p, __ATOMIC_RELAXED, __HIP_MEMORY_SCOPE_AGENT); }
__device__ __forceinline__ unsigned xb_add(unsigned* p, unsigned v) { return __hip_atomic_fetch_add(p, v, __ATOMIC_RELAXED, __HIP_MEMORY_SCOPE_AGENT); }
__device__ __forceinline__ unsigned xb_xcc_id() { return (unsigned)__builtin_amdgcn_s_getreg((3 << 11) | 20) & 0xFu; }
#define XB_SPIN(cond, bar) do { unsigned _sp = 0; while (cond) { __builtin_amdgcn_s_sleep(1); \
    if ((++_sp & 255u) == 0u) { if (xb_ld(&(bar)[XB_TMO])) break; if (_sp > XB_SPIN_CAP) { atomicAdd(&(bar)[XB_TMO], 1u); break; } } } } while (0)

struct XcdBarrier {
    unsigned* bar; unsigned x;
    volatile LAS unsigned* st;
};

__device__ __forceinline__ XcdBarrier xcd_barrier_post(unsigned* bar, volatile LAS unsigned* st) {
    XcdBarrier b; b.bar = bar; b.x = xb_xcc_id(); b.st = st;
    if (threadIdx.x == 0) (void)xb_add(&bar[XB_XCNT(b.x)], 1u);
    return b;
}
__device__ __forceinline__ void xcd_barrier_complete(unsigned* bar, unsigned x, unsigned& nloc, unsigned& nx) {
    const unsigned G = gridDim.x * gridDim.y * gridDim.z;
    unsigned sum, cnt, mine, sp = 0u;
    for (;;) {
        sum = 0u; cnt = 0u; mine = 0u;
#pragma unroll
        for (unsigned j = 0; j < 16; ++j) { const unsigned c = xb_ld(&bar[XB_XCNT(j)]); sum += c; cnt += (c > 0u) ? 1u : 0u; mine = (j == x) ? c : mine; }
        if (sum == G) break;
        __builtin_amdgcn_s_sleep(1);
        if ((++sp & 255u) == 0u) { if (xb_ld(&bar[XB_TMO])) break; if (sp > XB_SPIN_CAP) { atomicAdd(&bar[XB_TMO], 1u); break; } }
    }
    nloc = mine > 0u ? mine : 1u; nx = cnt > 0u ? cnt : 1u;
}

__device__ __forceinline__ void xcd_barrier(const XcdBarrier& b) {
    asm volatile("s_waitcnt vmcnt(0)" ::: "memory");
    __syncthreads();
    if (threadIdx.x == 0) {
        unsigned* bar = b.bar;
        __builtin_amdgcn_s_waitcnt(0);
        unsigned nloc = b.st[0], nx = b.st[1];
        if (nloc == 0u) { xcd_barrier_complete(bar, b.x, nloc, nx); b.st[0] = nloc; b.st[1] = nx; }
        const unsigned old = xb_add(&bar[XB_XSUB(b.x)], 1u);
        const unsigned gen = old / nloc;
        if (old + 1u == (gen + 1u) * nloc) {
            __builtin_amdgcn_fence(__ATOMIC_RELEASE, "agent");
            asm volatile("s_waitcnt vmcnt(0)" ::: "memory");
            const unsigned og = xb_add(&bar[XB_TOP], 1u);
            const unsigned tg = og / nx;
            if (og + 1u == (tg + 1u) * nx) xb_add(&bar[XB_TOPGEN], 1u);
            else XB_SPIN(xb_ld(&bar[XB_TOPGEN]) == tg, bar);
            __builtin_amdgcn_fence(__ATOMIC_ACQUIRE, "agent");
            xb_add(&bar[XB_XGEN(b.x)], 1u);
            asm volatile("s_waitcnt vmcnt(0)" ::: "memory");
        } else {
            XB_SPIN(xb_ld(&bar[XB_XGEN(b.x)]) == gen, bar);
            __builtin_amdgcn_fence(__ATOMIC_ACQUIRE, "agent");
            asm volatile("s_waitcnt vmcnt(0)" ::: "memory");
        }
    }
    __syncthreads();
}

typedef unsigned short bf16;
typedef short bf16x8 __attribute__((ext_vector_type(8)));
typedef short s16x4 __attribute__((ext_vector_type(4)));
typedef float f32x4 __attribute__((ext_vector_type(4)));
typedef float f32x16 __attribute__((ext_vector_type(16)));
typedef unsigned u32x4 __attribute__((ext_vector_type(4)));
typedef unsigned u32x2 __attribute__((ext_vector_type(2)));
typedef unsigned long long u64;

constexpr int NB = 2, SEQ = 8192, T = NB * SEQ, DM = 2048, MIXW = 1024, NH = 8, DH = 128;
constexpr int LD = 17152;
constexpr int C_G = 0, C_RQ = 6144, C_RK = 7168, C_RV = 8192, C_RG = 9216, C_CB = 10240, C_CC = 11264, C_CU = 12288, C_AQ = 13312, C_AK = 14336, C_AV = 15360,
              C_IQ = 16384, C_IK = 16896, C_IW = 16960;
constexpr int IN_COLS = 16968, SRC_GATES = 10824;
constexpr int DFF = 5632, NE = 8, DFFE = 7168, MAXSLOT = 2 * T + NE * 256;
constexpr float EPS = 1e-6f, LOG2E = 1.4426950408889634f;
constexpr int NWAVES = 8, NTHREADS = 512;
constexpr int SCB = 16384 * 2080;

constexpr size_t MiB = 1u << 20;
constexpr size_t WS_CTL = 0, CTL_ZERO_BYTES = 64 * 1024, WS_MISC = 1 * MiB;
constexpr size_t WS_WIN = 4 * MiB, WS_WBR = 138 * MiB, WS_WO = 162 * MiB, WS_W13 = 178 * MiB, WS_W2 = 222 * MiB, WS_M13 = 244 * MiB, WS_M2 = 692 * MiB;
constexpr size_t WS_XN = 916 * MiB, WS_PROJ = 980 * MiB, WS_KVS = 1516 * MiB, WS_SC = 1580 * MiB, WS_MASK = 1840 * MiB;
constexpr size_t WS_XB2 = 1710 * MiB, WS_SSQ = 1774 * MiB;
static_assert(WS_SC + 2ull * SCB * 2 <= WS_XB2 && WS_XB2 + (size_t)T * DM * 2 <= WS_SSQ && WS_SSQ + (size_t)T * 32 * 4 <= 1776 * MiB, "fused norm map");
constexpr size_t WS_XN8 = 1776 * MiB, WS_WIN8 = 1808 * MiB;
static_assert(WS_SC + 2ull * SCB * 2 <= WS_XN8 && WS_XN8 + (size_t)T * DM <= WS_WIN8 && WS_WIN8 + 2ull * 6144 * DM <= WS_MASK, "fp8 w_in map");
constexpr size_t WS_ACT = WS_PROJ;
constexpr size_t WS_HPERM = 980 * MiB, WS_MACT = 1116 * MiB, WS_YSLOT = 1592 * MiB, WS_PART = 1728 * MiB  , WS_END = 1864 * MiB;
static_assert(WS_YSLOT + (size_t)MAXSLOT * DM * 2 <= WS_PART && WS_PART + 256ull * 256 * 256 * 2 <= WS_END, "moe output map");
static_assert(WS_WIN + 2ull * LD * DM * 2 <= WS_WBR && WS_M13 + 8ull * 14336 * 2048 * 2 <= WS_M2 && WS_M2 + 8ull * 2048 * 7168 * 2 <= WS_XN, "weights map");
static_assert(WS_PROJ + (size_t)T * LD * 2 <= WS_KVS && WS_SC + 2ull * SCB * 4 <= WS_MASK && WS_MASK + 2ull * 128 * 8192 * 8 <= WS_END, "act map");
static_assert(WS_HPERM + (size_t)MAXSLOT * DM * 2 <= WS_MACT && WS_MACT + (size_t)MAXSLOT * DFFE * 2 <= WS_YSLOT && WS_YSLOT + (size_t)MAXSLOT * DM * 4 <= WS_END, "moe map");
constexpr size_t MS_POSMIN = 0, MS_POSMAX = 1024, MS_BIAS = 4096, MS_M2 = 12288, MS_TILES = 16384, MS_ROUTE = 65536, MS_TOKSLOT = 393216;
constexpr int BIAS_PITCH = 132;
constexpr int CW_BAR = 4096, CW_CNT = 8192, CW_CUR = 8256;

constexpr int PH_LDS = 143360;
constexpr int LDSCTL_OFF = PH_LDS, LDS_BYTES = 147456;

__device__ __forceinline__ float bf2f(unsigned v) { return __uint_as_float(v << 16); }
__device__ __forceinline__ float bflo(unsigned w) { return __uint_as_float(w << 16); }
__device__ __forceinline__ float bfhi(unsigned w) { return __uint_as_float(w & 0xffff0000u); }
__device__ __forceinline__ unsigned f2bf(float f) { unsigned u = __float_as_uint(f); return (u + 0x7fffu + ((u >> 16) & 1u)) >> 16; }
__device__ __forceinline__ unsigned pk2(float lo, float hi) { return pg8::cvt_pk_bf16(lo, hi); }
__device__ __forceinline__ float fast_exp2(float x) { return __builtin_amdgcn_exp2f(x); }
__device__ __forceinline__ float fast_rcp(float x) { return __builtin_amdgcn_rcpf(x); }
__device__ __forceinline__ float sigmoidf_(float x) { return fast_rcp(1.0f + fast_exp2(-x * LOG2E)); }
__device__ __forceinline__ int xshf_i(int v, int m, int lane) { return __builtin_amdgcn_ds_bpermute((lane ^ m) << 2, v); }
__device__ __forceinline__ float xshf(float v, int m, int lane) { return __int_as_float(__builtin_amdgcn_ds_bpermute((lane ^ m) << 2, __float_as_int(v))); }
__device__ __forceinline__ float lshf(float v, int src, int lane) { (void)lane; return __int_as_float(__builtin_amdgcn_ds_bpermute(src << 2, __float_as_int(v))); }
__device__ __forceinline__ int row16_sum_i(int v) {
    v += __builtin_amdgcn_update_dpp(0, v, 0xB1, 0xF, 0xF, true);
    v += __builtin_amdgcn_update_dpp(0, v, 0x4E, 0xF, 0xF, true);
    v += __builtin_amdgcn_update_dpp(0, v, 0x141, 0xF, 0xF, true);
    v += __builtin_amdgcn_update_dpp(0, v, 0x140, 0xF, 0xF, true);
    return v;
}
__device__ __forceinline__ float row16_sum_f(float v) {
    v += __int_as_float(__builtin_amdgcn_update_dpp(0, __float_as_int(v), 0xB1, 0xF, 0xF, true));
    v += __int_as_float(__builtin_amdgcn_update_dpp(0, __float_as_int(v), 0x4E, 0xF, 0xF, true));
    v += __int_as_float(__builtin_amdgcn_update_dpp(0, __float_as_int(v), 0x141, 0xF, 0xF, true));
    v += __int_as_float(__builtin_amdgcn_update_dpp(0, __float_as_int(v), 0x140, 0xF, 0xF, true));
    return v;
}
__device__ __forceinline__ float wave_sum(float v, int lane) { (void)lane; v = row16_sum_f(v);
    return (__int_as_float(__builtin_amdgcn_readlane(__float_as_int(v), 0)) + __int_as_float(__builtin_amdgcn_readlane(__float_as_int(v), 16))) +
           (__int_as_float(__builtin_amdgcn_readlane(__float_as_int(v), 32)) + __int_as_float(__builtin_amdgcn_readlane(__float_as_int(v), 48))); }
__device__ __forceinline__ float log2gamma(int h) { return log2f(1.0f - exp2f((float)(-5 - h))); }
#define LDS_WAIT() asm volatile("s_waitcnt lgkmcnt(0)" ::: "memory")
#define VM_WAIT() asm volatile("s_waitcnt vmcnt(0)" ::: "memory")

namespace pg8 {
struct EpiProj {
    static constexpr bool PERM = true, AFTER_DRAIN = false; static constexpr int MIDK = 0;
    bf16_t* O; int ngate; float gsc;
    const PG8_LAS float* rs; int rbase;
    __device__ __forceinline__ void operator()(const f32x4 (&acc)[2][2][4][2], const Unit& u, int wr, int wc, int fr, int fq) const {
        const int row0 = u.pm * BM + wr * 64 + fr, col0 = u.pn * BM + wc * 32 + 8 * fq; const bool sg = u.pn < ngate;
#pragma unroll
        for (int ai = 0; ai < 2; ++ai)
#pragma unroll
            for (int m = 0; m < 4; ++m) { bf16_t* rowp = O + (size_t)(row0 + ai * HALF + m * 16) * LD + col0; const float rr = (rs ? rs[(row0 + ai * HALF + m * 16 - rbase) & 2047] : 1.0f) * gsc;
#pragma unroll
                for (int bj = 0; bj < 2; ++bj) { f32x4 v0 = acc[ai][bj][m][0] * rr, v1 = acc[ai][bj][m][1] * rr;
                    if (sg) {
#pragma unroll
                        for (int j = 0; j < 4; ++j) { v0[j] = __builtin_amdgcn_fmed3f(sigmoidf_(v0[j]), 1.0e-6f, 1.0f); v1[j] = __builtin_amdgcn_fmed3f(sigmoidf_(v1[j]), 1.0e-6f, 1.0f); } }
                    u32x4 w; w.x = cvt_pk_bf16(v0[0], v0[1]); w.y = cvt_pk_bf16(v0[2], v0[3]); w.z = cvt_pk_bf16(v1[0], v1[1]); w.w = cvt_pk_bf16(v1[2], v1[3]);
                    *(u32x4*)(rowp + bj * HALF) = w; } }
    }
};
struct EpiProjQK {
    static constexpr bool PERM = true, AFTER_DRAIN = false; static constexpr int MIDK = 0;
    bf16_t* O; float gsc; const float* qn; const float* kn; const PG8_LAS float* rs; int rbase; PG8_LAS float* xl;
    __device__ __forceinline__ void operator()(const f32x4 (&acc)[2][2][4][2], const Unit& u, int wr, int wc, int fr, int fq) const {
        const int row0 = u.pm * BM + wr * 64 + fr, col0 = u.pn * BM + wc * 32 + 8 * fq;
        if (u.pn < 8) {
            const bool isq = u.pn < 4; const float* gp = (isq ? qn : kn) + wc * 32 + 8 * fq; const f32x4 g0 = *(const f32x4*)gp, g1 = *(const f32x4*)(gp + 4);
            const float hs = isq ? 0.08838834764831845f * LOG2E : 1.0f; const int lane = fr + 16 * fq;
#pragma unroll
            for (int ai = 0; ai < 2; ++ai) { float rr[4];
#pragma unroll
                for (int m = 0; m < 4; ++m) { rr[m] = (rs ? rs[(row0 + ai * HALF + m * 16 - rbase) & 2047] : 1.0f) * gsc;
#pragma unroll
                    for (int bj = 0; bj < 2; ++bj) { const f32x4 a = acc[ai][bj][m][0] * rr[m], b = acc[ai][bj][m][1] * rr[m];
                        float sq = ((a[0] * a[0] + a[1] * a[1]) + (a[2] * a[2] + a[3] * a[3])) + ((b[0] * b[0] + b[1] * b[1]) + (b[2] * b[2] + b[3] * b[3]));
                        sq += xshf(sq, 16, lane); sq += xshf(sq, 32, lane);
                        if (fq == 0) xl[(((wr * 64 + m * 16 + fr) * 2 + bj) << 2) + wc] = sq; } }
                asm volatile("s_waitcnt lgkmcnt(0)\n\ts_barrier" ::: "memory");
#pragma unroll
                for (int m = 0; m < 4; ++m) { bf16_t* rowp = O + (size_t)(row0 + ai * HALF + m * 16) * LD + col0;
#pragma unroll
                    for (int bj = 0; bj < 2; ++bj) { const f32x4 pt = *(const PG8_LAS f32x4*)(xl + (((wr * 64 + m * 16 + fr) * 2 + bj) << 2));
                        const float tot = (pt[0] + pt[1]) + (pt[2] + pt[3]); const float sc = rr[m] * hs / sqrtf(tot * (1.0f / 128.0f) + EPS);
                        const f32x4 v0 = acc[ai][bj][m][0] * sc * g0, v1 = acc[ai][bj][m][1] * sc * g1;
                        u32x4 w; w.x = cvt_pk_bf16(v0[0], v0[1]); w.y = cvt_pk_bf16(v0[2], v0[3]); w.z = cvt_pk_bf16(v1[0], v1[1]); w.w = cvt_pk_bf16(v1[2], v1[3]);
                        *(u32x4*)(rowp + bj * HALF) = w; } }
                asm volatile("s_waitcnt lgkmcnt(0)\n\ts_barrier" ::: "memory"); }
        } else {
#pragma unroll
            for (int ai = 0; ai < 2; ++ai)
#pragma unroll
                for (int m = 0; m < 4; ++m) { const int row = row0 + ai * HALF + m * 16; bf16_t* rowp = O + (size_t)row * LD + col0; const float rr = (rs ? rs[(row - rbase) & 2047] : 1.0f) * gsc;
#pragma unroll
                    for (int bj = 0; bj < 2; ++bj) { const f32x4 v0 = acc[ai][bj][m][0] * rr, v1 = acc[ai][bj][m][1] * rr;
                        u32x4 w; w.x = cvt_pk_bf16(v0[0], v0[1]); w.y = cvt_pk_bf16(v0[2], v0[3]); w.z = cvt_pk_bf16(v1[0], v1[1]); w.w = cvt_pk_bf16(v1[2], v1[3]);
                        *(u32x4*)(rowp + bj * HALF) = w; } }
        }
    }
};
struct EpiProjRot {
    static constexpr bool PERM = true, AFTER_DRAIN = false; static constexpr int MIDK = 0;
    bf16_t* O; const int* pos; const PG8_LAS float* rs; int rbase;
    __device__ __forceinline__ void operator()(const f32x4 (&acc)[2][2][4][2], const Unit& u, int wr, int wc, int fr, int fq) const {
        const int row0 = u.pm * BM + wr * 64 + fr, col0 = u.pn * BM + wc * 32 + 8 * fq;
        if (u.pn < 8) {
            float invf[4];
#pragma unroll
            for (int j = 0; j < 4; ++j) invf[j] = __builtin_amdgcn_exp2f(-(float)(4 * (wc * 4 + fq) + j) * 0.20762050593046014f) * 0.15915494309189535f;
            const float ksc = u.pn < 4 ? 1.0f : 0.08838834764831845f;
#pragma unroll
            for (int ai = 0; ai < 2; ++ai)
#pragma unroll
                for (int m = 0; m < 4; ++m) { const int row = row0 + ai * HALF + m * 16; bf16_t* rowp = O + (size_t)row * LD + col0; const float rr = (rs ? rs[(row - rbase) & 2047] : 1.0f) * ksc; const float pf = (float)pos[row];
                    float sn[4], cs[4];
#pragma unroll
                    for (int j = 0; j < 4; ++j) { const float rev = pf * invf[j]; const float frc = rev - __builtin_floorf(rev); sn[j] = __builtin_amdgcn_sinf(frc); cs[j] = __builtin_amdgcn_cosf(frc); }
#pragma unroll
                    for (int bj = 0; bj < 2; ++bj) { const f32x4 x = acc[ai][bj][m][0] * rr, y = acc[ai][bj][m][1] * rr; f32x4 v0, v1;
#pragma unroll
                        for (int j = 0; j < 4; ++j) { v0[j] = x[j] * cs[j] - y[j] * sn[j]; v1[j] = x[j] * sn[j] + y[j] * cs[j]; }
                        u32x4 w; w.x = cvt_pk_bf16(v0[0], v0[1]); w.y = cvt_pk_bf16(v0[2], v0[3]); w.z = cvt_pk_bf16(v1[0], v1[1]); w.w = cvt_pk_bf16(v1[2], v1[3]);
                        *(u32x4*)(rowp + bj * HALF) = w; } }
        } else {
#pragma unroll
            for (int ai = 0; ai < 2; ++ai)
#pragma unroll
                for (int m = 0; m < 4; ++m) { const int row = row0 + ai * HALF + m * 16; bf16_t* rowp = O + (size_t)row * LD + col0; const float rr = rs ? rs[(row - rbase) & 2047] : 1.0f;
#pragma unroll
                    for (int bj = 0; bj < 2; ++bj) { const f32x4 v0 = acc[ai][bj][m][0] * rr, v1 = acc[ai][bj][m][1] * rr;
                        u32x4 w; w.x = cvt_pk_bf16(v0[0], v0[1]); w.y = cvt_pk_bf16(v0[2], v0[3]); w.z = cvt_pk_bf16(v1[0], v1[1]); w.w = cvt_pk_bf16(v1[2], v1[3]);
                        *(u32x4*)(rowp + bj * HALF) = w; } }
        }
    }
};
struct EpiGate3 {
    static constexpr bool PERM = true, AFTER_DRAIN = false; static constexpr int MIDK = 16;
    const bf16_t* G; bf16_t* MB;
    __device__ __forceinline__ void mid(f32x4 (&acc)[2][2][4][2], const Unit& u, int wr, int wc, int fr, int fq, int seg) const {
        asm volatile("" : "+v"(fr), "+v"(fq));
        const int row0 = u.pm * BM + wr * 64 + fr, col0 = u.pn * BM + wc * 32 + 8 * fq; const bf16_t* Ga = G + (size_t)(seg - 1) * DM, * Gb = G + (size_t)seg * DM;
#pragma unroll
        for (int ai = 0; ai < 2; ++ai) { u32x4 ga[4][2], gb[4][2];
#pragma unroll
            for (int m = 0; m < 4; ++m)
#pragma unroll
                for (int bj = 0; bj < 2; ++bj) { const size_t o = (size_t)(row0 + ai * HALF + m * 16) * LD + col0 + bj * HALF; ga[m][bj] = *(const u32x4*)(Ga + o); gb[m][bj] = *(const u32x4*)(Gb + o); }
            asm volatile("" ::: "memory");
#pragma unroll
            for (int m = 0; m < 4; ++m)
#pragma unroll
                for (int bj = 0; bj < 2; ++bj) { const u32x4 a = ga[m][bj], b = gb[m][bj];
                    const f32x4 r0 = {bflo(a.x) * fast_rcp(bflo(b.x)), bfhi(a.x) * fast_rcp(bfhi(b.x)), bflo(a.y) * fast_rcp(bflo(b.y)), bfhi(a.y) * fast_rcp(bfhi(b.y))};
                    const f32x4 r1 = {bflo(a.z) * fast_rcp(bflo(b.z)), bfhi(a.z) * fast_rcp(bfhi(b.z)), bflo(a.w) * fast_rcp(bflo(b.w)), bfhi(a.w) * fast_rcp(bfhi(b.w))};
                    acc[ai][bj][m][0] *= r0; acc[ai][bj][m][1] *= r1; }
            asm volatile("" ::: "memory"); }
    }
    __device__ __forceinline__ void operator()(const f32x4 (&acc)[2][2][4][2], const Unit& u, int wr, int wc, int fr, int fq) const {
        const int row0 = u.pm * BM + wr * 64 + fr, col0 = u.pn * BM + wc * 32 + 8 * fq; const bf16_t* G2 = G + (size_t)2 * DM;
#pragma unroll
        for (int ai = 0; ai < 2; ++ai) { u32x4 gg[4][2];
#pragma unroll
            for (int m = 0; m < 4; ++m)
#pragma unroll
                for (int bj = 0; bj < 2; ++bj) gg[m][bj] = *(const u32x4*)(G2 + (size_t)(row0 + ai * HALF + m * 16) * LD + col0 + bj * HALF);
            asm volatile("" ::: "memory");
#pragma unroll
            for (int m = 0; m < 4; ++m)
#pragma unroll
                for (int bj = 0; bj < 2; ++bj) { const u32x4 gw = gg[m][bj];
                    const f32x4 g0 = {bflo(gw.x), bfhi(gw.x), bflo(gw.y), bfhi(gw.y)}, g1 = {bflo(gw.z), bfhi(gw.z), bflo(gw.w), bfhi(gw.w)};
                    const f32x4 v0 = acc[ai][bj][m][0] * g0, v1 = acc[ai][bj][m][1] * g1;
                    u32x4 w; w.x = cvt_pk_bf16(v0[0], v0[1]); w.y = cvt_pk_bf16(v0[2], v0[3]); w.z = cvt_pk_bf16(v1[0], v1[1]); w.w = cvt_pk_bf16(v1[2], v1[3]);
                    *(u32x4*)(MB + (size_t)(row0 + ai * HALF + m * 16) * DM + col0 + bj * HALF) = w; }
            asm volatile("" ::: "memory"); }
    }
};
struct EpiResid {
    static constexpr bool PERM = false, AFTER_DRAIN = false; static constexpr int MIDK = 0;
    const float* src; float* out;
    const PG8_LAS float* ng  ; bf16_t* XB; unsigned char* XB8; float* SSQ;
    __device__ __forceinline__ void operator()(const f32x4 (&acc)[2][2][4][2], const Unit& u, int wr, int wc, int fr, int fq) const {
        const int row0 = u.pm * BM + wr * 64 + fr, col0 = u.pn * BM + wc * 32 + 4 * fq; const bool nx = XB != nullptr;
        const int lane = fr + 16 * fq;
#pragma unroll
        for (int ai = 0; ai < 2; ++ai) { f32x4 sv[4][2][2];
#pragma unroll
            for (int m = 0; m < 4; ++m)
#pragma unroll
                for (int bj = 0; bj < 2; ++bj)
#pragma unroll
                    for (int n = 0; n < 2; ++n) sv[m][bj][n] = *(const f32x4*)(src + (size_t)(row0 + ai * HALF + m * 16) * DM + col0 + bj * HALF + n * 16);
            asm volatile("" ::: "memory");
#pragma unroll
            for (int m = 0; m < 4; ++m)
#pragma unroll
                for (int bj = 0; bj < 2; ++bj)
#pragma unroll
                    for (int n = 0; n < 2; ++n) { sv[m][bj][n] = sv[m][bj][n] + acc[ai][bj][m][n]; *(f32x4*)(out + (size_t)(row0 + ai * HALF + m * 16) * DM + col0 + bj * HALF + n * 16) = sv[m][bj][n]; }
            asm volatile("" ::: "memory");
            if (nx) {
#pragma unroll
                for (int m = 0; m < 4; ++m) { float sq = 0.f;
#pragma unroll
                    for (int bj = 0; bj < 2; ++bj)
#pragma unroll
                        for (int n = 0; n < 2; ++n) { const f32x4 r = sv[m][bj][n]; const size_t o = (size_t)(row0 + ai * HALF + m * 16) * DM + col0 + bj * HALF + n * 16;
                            sq += (r[0] * r[0] + r[1] * r[1]) + (r[2] * r[2] + r[3] * r[3]); const f32x4 y = r * *(const PG8_LAS f32x4*)(ng + col0 + bj * HALF + n * 16);
                            typedef unsigned u32x2_t __attribute__((ext_vector_type(2)));
                            *(u32x2_t*)(XB + o) = (u32x2_t){cvt_pk_bf16(y[0], y[1]), cvt_pk_bf16(y[2], y[3])};
                            if (XB8) *(unsigned*)(XB8 + o) = cvt_pk4_fp8(__builtin_amdgcn_fmed3f(y[0], -448.f, 448.f), __builtin_amdgcn_fmed3f(y[1], -448.f, 448.f), __builtin_amdgcn_fmed3f(y[2], -448.f, 448.f), __builtin_amdgcn_fmed3f(y[3], -448.f, 448.f)); }
                    sq += xshf(sq, 16, lane); sq += xshf(sq, 32, lane);
                    if (fq == 0) SSQ[(size_t)(row0 + ai * HALF + m * 16) * 32 + (u.pn & 7) * 4 + wc] = sq; }
                asm volatile("" ::: "memory"); } }
    }
};
struct EpiSwiglu {
    static constexpr bool PERM = true, AFTER_DRAIN = false; static constexpr int MIDK = 0;
    bf16_t* O; int ldo, nper; const PG8_LAS float* rs; int rbase;
    __device__ __forceinline__ void operator()(const f32x4 (&acc)[2][2][4][2], const Unit& u, int wr, int wc, int fr, int fq) const {
        const int row0 = u.pm * BM + wr * 64 + fr, col0 = (u.pn % nper) * HALF + wc * 32 + 8 * fq;
#pragma unroll
        for (int ai = 0; ai < 2; ++ai)
#pragma unroll
            for (int m = 0; m < 4; ++m) { bf16_t* rowp = O + (size_t)(row0 + ai * HALF + m * 16) * ldo + col0; const float rr = rs ? rs[(row0 + ai * HALF + m * 16 - rbase) & 2047] : 1.0f;
                f32x4 v0, v1;
#pragma unroll
                for (int j = 0; j < 4; ++j) { const float a = acc[ai][0][m][0][j] * rr, b = acc[ai][0][m][1][j] * rr;
                    v0[j] = a * sigmoidf_(a) * (acc[ai][1][m][0][j] * rr); v1[j] = b * sigmoidf_(b) * (acc[ai][1][m][1][j] * rr); }
                u32x4 w; w.x = cvt_pk_bf16(v0[0], v0[1]); w.y = cvt_pk_bf16(v0[2], v0[3]); w.z = cvt_pk_bf16(v1[0], v1[1]); w.w = cvt_pk_bf16(v1[2], v1[3]);
                *(u32x4*)rowp = w; }
    }
};
struct EpiSwigluF8 {
    static constexpr bool PERM = true, AFTER_DRAIN = false; static constexpr int MIDK = 0;
    unsigned char* O; int ldo, nper;
    static __device__ __forceinline__ float act(float G, float U) { constexpr float ka = -LOG2E / F8_WSCALE, ki = F8_WSCALE * F8_WSCALE / F8_ASCALE;
        return __builtin_amdgcn_fmed3f((G * U) * fast_rcp(__builtin_fmaf(fast_exp2(G * ka), ki, ki)), -448.f, 448.f); }
    __device__ __forceinline__ void operator()(const f32x4 (&acc)[2][2][4][2], const Unit& u, int wr, int wc, int fr, int fq) const {
        asm volatile("" : "+v"(fr), "+v"(fq));
        const int row0 = u.pm * BM + wr * 64 + fr, col0 = (u.pn % nper) * HALF + wc * 32 + 8 * fq;
#pragma unroll
        for (int ai = 0; ai < 2; ++ai)
#pragma unroll
            for (int m = 0; m < 4; ++m) { unsigned char* rowp = O + (size_t)(row0 + ai * HALF + m * 16) * ldo + col0;
                f32x4 v0, v1;
#pragma unroll
                for (int j = 0; j < 4; ++j) { v0[j] = act(acc[ai][0][m][0][j], acc[ai][1][m][0][j]); v1[j] = act(acc[ai][0][m][1][j], acc[ai][1][m][1][j]); }
                typedef unsigned u32x2_t __attribute__((ext_vector_type(2)));
                *(u32x2_t*)rowp = (u32x2_t){cvt_pk4_fp8(v0[0], v0[1], v0[2], v0[3]), cvt_pk4_fp8(v1[0], v1[1], v1[2], v1[3])}; }
    }
};
struct EpiBf16Slot {
    static constexpr bool PERM = true, AFTER_DRAIN = false; static constexpr int MIDK = 0;
    bf16_t* Y; bf16_t* PART; float sc;
    __device__ __forceinline__ void operator()(const f32x4 (&acc)[2][2][4][2], const Unit& u, int wr, int wc, int fr, int fq) const {
        const bool part = u.z != 0; asm volatile("" : "+v"(fr), "+v"(fq));
        const int row0 = (part ? 0 : u.pm * BM) + wr * 64 + fr, col0 = (part ? 0 : (u.pn & 7) * BM) + wc * 32 + 8 * fq; const int ldy = part ? BM : DM;
        bf16_t* base = part ? PART + (size_t)(u.z - 1) * (BM * BM) : Y;
#pragma unroll
        for (int ai = 0; ai < 2; ++ai)
#pragma unroll
            for (int m = 0; m < 4; ++m) { bf16_t* rowp = base + (size_t)(row0 + ai * HALF + m * 16) * ldy + col0;
#pragma unroll
                for (int bj = 0; bj < 2; ++bj) { const f32x4 v0 = acc[ai][bj][m][0] * sc, v1 = acc[ai][bj][m][1] * sc;
                    u32x4 w; w.x = cvt_pk_bf16(v0[0], v0[1]); w.y = cvt_pk_bf16(v0[2], v0[3]); w.z = cvt_pk_bf16(v1[0], v1[1]); w.w = cvt_pk_bf16(v1[2], v1[3]);
                    *(u32x4*)(rowp + bj * HALF) = w; } }
    }
};
struct MoeOrder {
    int nN, nwg, G, c, ntiles, full, rem, ks, ksl, ntl; int cum[9];
    __device__ __forceinline__ void init(const int* tiles  , int nN_, int G_, int c_, bool tsplit = false, int K = 0) {
#pragma unroll
        for (int e = 0; e < 9; ++e) cum[e] = __builtin_amdgcn_readfirstlane(tiles[e]);
        ntiles = cum[8]; nN = nN_; nwg = ntiles * nN; G = G_; c = c_; full = nwg / G; rem = nwg - full * G;
        ks = tsplit ? tail_split(rem, G, K) : 1;
        ksl = K / ks; ntl = ksl / BK; }
    static __device__ __forceinline__ int tail_split(int rem, int G, int K) {
        if (rem <= 0) return 1;
        if (8 * rem <= G && K % (8 * 128) == 0) return 8; if (4 * rem <= G && K % (4 * 128) == 0) return 4; if (2 * rem <= G && K % (2 * 128) == 0) return 2; return 1; }
    __device__ __forceinline__ void tile_of(int L, int& pm, int& pn) const {
        const int nig = WGM * nN, gid = L / nig, fm = gid * WGM, gsz = (ntiles - fm) < WGM ? (ntiles - fm) : WGM;
        pm = fm + ((L % nig) % gsz); const int pnl = (L % nig) / gsz; int e = 0;
#pragma unroll
        for (int k = 1; k < 8; ++k) e += (pm >= cum[k]) ? 1 : 0;
        pn = e * nN + pnl; }
    __device__ __forceinline__ bool next(int i, Unit& u) const {
        if (i < full || ks == 1) { int cc = c; if (G == 256) { const int x = c & 7, j = c >> 3; cc = ((4 * x + (j >> 3)) << 3) + (j & 7); }
            const long L = (long)i * G + cc; if (L >= nwg) return false; tile_of((int)L, u.pm, u.pn); u.koff = 0; u.nt = 0; u.z = 0; return true; }
        if (i > full || c >= ks * rem) return false;
        const int ti = c / ks, kh = c - ti * ks; tile_of(full * G + ti, u.pm, u.pn); u.koff = kh * ksl; u.nt = ntl; u.z = 1 + c; return true;
    }
    __device__ __forceinline__ void a_ready(const Unit&) const {}
    __device__ __forceinline__ void done(const Unit&) const {}
};
}

struct Args { const void* in[20]; float* out; unsigned char* ws; int ph_lo, ph_hi; };
struct Frame {
    LAS unsigned char* lds; int tid, lane, wave, G, bx;
    unsigned char* ws;
};

struct MapId { __device__ __forceinline__ int operator()(int n) const { return n; } };
struct MapWin { __device__ __forceinline__ int operator()(int s) const {
    if (s < 2048) { const int d = s & 127; return 6144 + (s & ~127) + 8 * ((d & 63) >> 2) + 4 * (d >> 6) + (d & 3); }
    return s < SRC_GATES ? s + 6144 : s - SRC_GATES; } };
struct MapSwi { int add; __device__ __forceinline__ int operator()(int j) const { return ((j >> 7) << 8) + (j & 127) + add; } };
template <class Map>
__device__ __forceinline__ void conv_item(const float* W, int N, int kb, int nb, bf16* WT, int Kd, const Map& map, int lane, unsigned char* W8 = nullptr, int f8from = 0x7fffffff, unsigned char* W8b = nullptr, int f8b_lo = 0x7fffffff, int f8b_hi = 0x7fffffff) {
    const int k0 = 64 * kb + 16 * (lane >> 4), n = 64 * nb + 4 * (lane & 15); const bool ok = n < N;
    f32x4 v[16];
    const float* src = W + (size_t)k0 * N + (ok ? n : 0);
#pragma unroll
    for (int i = 0; i < 16; ++i) v[i] = __builtin_nontemporal_load((const f32x4*)(src + (size_t)i * N));
    const bool inb = n >= f8b_lo && n < f8b_hi;
    if (ok && (n >= f8from || inb)) { unsigned char* w8 = inb ? W8b : W8; const int r8 = inb ? n - f8b_lo : n - f8from;
#define F8W(x) __builtin_amdgcn_fmed3f((x) * pg8::F8_WSCALE, -448.f, 448.f)
#pragma unroll
        for (int j = 0; j < 4; ++j) *(u32x4*)(w8 + (size_t)(r8 + j) * Kd + k0) = (u32x4){pg8::cvt_pk4_fp8(F8W(v[0][j]), F8W(v[1][j]), F8W(v[2][j]), F8W(v[3][j])), pg8::cvt_pk4_fp8(F8W(v[4][j]), F8W(v[5][j]), F8W(v[6][j]), F8W(v[7][j])),
            pg8::cvt_pk4_fp8(F8W(v[8][j]), F8W(v[9][j]), F8W(v[10][j]), F8W(v[11][j])), pg8::cvt_pk4_fp8(F8W(v[12][j]), F8W(v[13][j]), F8W(v[14][j]), F8W(v[15][j]))};
#undef F8W
    } else if (ok) {
#pragma unroll
        for (int j = 0; j < 4; ++j) { bf16* dst = WT + (size_t)map(n + j) * Kd + k0;
            *(u32x4*)dst = (u32x4){pk2(v[0][j], v[1][j]), pk2(v[2][j], v[3][j]), pk2(v[4][j], v[5][j]), pk2(v[6][j], v[7][j])};
            *(u32x4*)(dst + 8) = (u32x4){pk2(v[8][j], v[9][j]), pk2(v[10][j], v[11][j]), pk2(v[12][j], v[13][j]), pk2(v[14][j], v[15][j])}; } }
}
template <class Map>
__device__ __forceinline__ void conv_seg(const Frame& F, const float* src, int nmat, int K, int N, bf16* dst, size_t dstride, const Map& map, int Kd = 0, unsigned char* dst8 = nullptr, size_t dstride8 = 0, int f8from = 0x7fffffff, unsigned char* dst8b = nullptr, size_t dstride8b = 0, int f8b_lo = 0x7fffffff, int f8b_hi = 0x7fffffff) {
    if (Kd == 0) Kd = K;
    const int gw = F.bx * NWAVES + F.wave, NGW = F.G * NWAVES;
    const int nkb = K / 64, nnb = (N + 63) / 64, per = nkb * nnb, total = nmat * per;
    for (int it = gw; it < total; it += NGW) { const int mat = it / per, r = it - mat * per, kb = r / nnb, nb = r - kb * nnb;
        conv_item(src + (size_t)mat * K * N, N, kb, nb, dst + (size_t)mat * dstride, Kd, map, F.lane, dst8 ? dst8 + (size_t)mat * dstride8 : nullptr, f8from, dst8b ? dst8b + (size_t)mat * dstride8b : nullptr, f8b_lo, f8b_hi); }
}
constexpr int CVM_PER = 8 * 32 * 112, CVM_TOTAL = 3 * CVM_PER, CVM_BG = 65536, CVM_LAYER = 32768, CVM_SEL = 0, CVM_KV = 16384, CVM_RET = 24576;
static_assert(CVM_BG <= CVM_TOTAL && 2 * CVM_LAYER == CVM_BG && CVM_RET + 1024 * 8 == CVM_LAYER && CVM_KV + 1024 * 8 == CVM_RET && CVM_KV == T, "background conversion slots");
struct CvmCtx { const float* w1; const float* w3; const float* w2; unsigned char* m13; unsigned char* m2; };
struct CvmLane { const float* src; unsigned char* dst; int N, Kd; };
__device__ __forceinline__ CvmLane cvm_lane(const CvmCtx& c, int id  , int lane) {
    const int seg = id / CVM_PER, r = id - seg * CVM_PER, mat = r / 3584, r2 = r - mat * 3584; CvmLane L;
    if (seg < 2) { const int kb = r2 / 112, nb = r2 - kb * 112, k0 = 64 * kb + 16 * (lane >> 4), n = 64 * nb + 4 * (lane & 15);
        L.N = DFFE; L.Kd = DM; L.src = (seg ? c.w3 : c.w1) + (size_t)mat * DM * DFFE + (size_t)k0 * DFFE + n;
        L.dst = c.m13 + (size_t)mat * 2 * DFFE * DM + (size_t)(((n >> 7) << 8) + (n & 127) + (seg ? 128 : 0)) * DM + k0; }
    else { const int kb = r2 >> 5, nb = r2 & 31, k0 = 64 * kb + 16 * (lane >> 4), n = 64 * nb + 4 * (lane & 15);
        L.N = DM; L.Kd = DFFE; L.src = c.w2 + (size_t)mat * DFFE * DM + (size_t)k0 * DM + n; L.dst = c.m2 + (size_t)mat * DM * DFFE + (size_t)n * DFFE + k0; }
    return L;
}
template <int H> __device__ __forceinline__ void cvm_load(const CvmLane& L, f32x4 (&v)[8]) {
#pragma unroll
    for (int i = 0; i < 8; ++i) v[i] = __builtin_nontemporal_load((const f32x4*)(L.src + (size_t)(8 * H + i) * L.N));
}
template <int H> __device__ __forceinline__ void cvm_store(const CvmLane& L, const f32x4 (&v)[8]) {
#pragma unroll
    for (int j = 0; j < 4; ++j) { constexpr float w = pg8::F8_WSCALE;
#define F8W(x) __builtin_amdgcn_fmed3f((x) * w, -448.f, 448.f)
        *(u32x2*)(L.dst + (size_t)j * L.Kd + 8 * H) = (u32x2){pg8::cvt_pk4_fp8(F8W(v[0][j]), F8W(v[1][j]), F8W(v[2][j]), F8W(v[3][j])), pg8::cvt_pk4_fp8(F8W(v[4][j]), F8W(v[5][j]), F8W(v[6][j]), F8W(v[7][j]))}; }
#undef F8W
}

__device__ __forceinline__ void ph_prologue(const Frame& F, const Args& a) {
    unsigned char* ws = F.ws;
    conv_seg(F, (const float*)a.in[5], 2, DM, IN_COLS, (bf16*)(ws + WS_WIN), (size_t)LD * DM, MapWin{}, 0, ws + WS_WIN8, (size_t)6144 * DM, SRC_GATES, ws + WS_WIN, (size_t)LD * DM * 2, C_AQ - 6144, C_AQ - 6144 + 3072);
    for (int l = 0; l < 2; ++l)
        conv_seg(F, (const float*)a.in[6] + (size_t)l * 3 * MIXW * DM, 3, MIXW, DM, (bf16*)(ws + WS_WBR) + (size_t)l * DM * 3 * MIXW, (size_t)MIXW, MapId{}, 3 * MIXW);
    conv_seg(F, (const float*)a.in[7], 2, DM, DM, (bf16*)(ws + WS_WO), (size_t)DM * DM, MapId{});
    conv_seg(F, (const float*)a.in[13], 1, DM, DFF, (bf16*)(ws + WS_W13), 0, MapSwi{0});
    conv_seg(F, (const float*)a.in[14], 1, DM, DFF, (bf16*)(ws + WS_W13), 0, MapSwi{128});
    conv_seg(F, (const float*)a.in[15], 1, DFF, DM, (bf16*)(ws + WS_W2), 0, MapId{});
    { const CvmCtx cc{(const float*)a.in[17], (const float*)a.in[18], (const float*)a.in[19], ws + WS_M13, ws + WS_M2};
      const int gw = F.bx * NWAVES + F.wave, NGW = F.G * NWAVES;
      for (int id = CVM_BG + gw; id < CVM_TOTAL; id += NGW) { const CvmLane L = cvm_lane(cc, id, F.lane); f32x4 v0[8], v1[8]; cvm_load<0>(L, v0); cvm_load<1>(L, v1); cvm_store<0>(L, v0); cvm_store<1>(L, v1); } }
    const int gt = F.bx * NTHREADS + F.tid, NGT = F.G * NTHREADS;
    for (int l = 0; l < 2; ++l) { u32x4* p = (u32x4*)((bf16*)(ws + WS_WIN) + (size_t)l * LD * DM + (size_t)IN_COLS * DM);
        for (int i = gt; i < (LD - IN_COLS) * DM / 8; i += NGT) p[i] = (u32x4){0u, 0u, 0u, 0u}; }
    const int* pos = (const int*)a.in[1];
    { const int gw = F.bx * NWAVES + F.wave, NGW = F.G * NWAVES;
      for (int blk = gw; blk < T / 64; blk += NGW) { int v = pos[blk * 64 + F.lane], mn = v, mx = v;
#pragma unroll
          for (int o = 1; o < 64; o <<= 1) { const int a1 = xshf_i(mn, o, F.lane), b1 = xshf_i(mx, o, F.lane); mn = a1 < mn ? a1 : mn; mx = b1 > mx ? b1 : mx; }
          if (F.lane == 0) { ((int*)(ws + WS_MISC + MS_POSMIN))[blk] = mn; ((int*)(ws + WS_MISC + MS_POSMAX))[blk] = mx; } } }
    const float* rb = (const float*)a.in[2];
    if (gt < NH * BIAS_PITCH) { const int h = gt / BIAS_PITCH, d = gt % BIAS_PITCH; int bucket;
        if (d < 16) bucket = d; else { const float v = logf((float)d / 16.0f) / 2.0794415416798357f * 16.0f; bucket = 16 + (int)v; bucket = bucket > 31 ? 31 : bucket; }
        if (d > 128) bucket = 31;
        ((float*)(ws + WS_MISC + MS_BIAS))[gt] = rb[bucket * NH + h] * LOG2E; }
    if (F.bx == 0 && F.wave == 0) {
        float mb = 0.f;
#pragma unroll
        for (int i = 0; i < 4; ++i) mb = fmaxf(mb, fabsf(rb[F.lane * 4 + i]));
#pragma unroll
        for (int o = 1; o < 64; o <<= 1) mb = fmaxf(mb, xshf(mb, o, F.lane));
        for (int l = 0; l < 2; ++l) { const float* qn = (const float*)a.in[11] + l * DH; const float* kn = (const float*)a.in[12] + l * DH;
            float mq = fmaxf(fabsf(qn[F.lane]), fabsf(qn[F.lane + 64])), mk = fmaxf(fabsf(kn[F.lane]), fabsf(kn[F.lane + 64]));
#pragma unroll
            for (int o = 1; o < 64; o <<= 1) { mq = fmaxf(mq, xshf(mq, o, F.lane)); mk = fmaxf(mk, xshf(mk, o, F.lane)); }
            if (F.lane == 0) ((float*)(ws + WS_MISC + MS_M2))[l] = (11.313708499f * mq * mk * 1.02f + mb) * LOG2E; } }
}

template <bool ROUTER>
__device__ __forceinline__ void ph_rmsnorm(const Frame& F, const float* x, const float* g, bf16* XN, const float* R  , u32x4* route, unsigned* cnt, unsigned char* XN8 = nullptr  ) {
    const int gw = F.bx * NWAVES + F.wave, NGW = F.G * NWAVES;
    volatile LAS unsigned* lcnt = (volatile LAS unsigned*)(F.lds);
    if (ROUTER) { if (F.tid < NE) lcnt[F.tid] = 0u; __syncthreads(); }
    for (int m = gw; m < T; m += NGW) {
        const f32x4* xr = (const f32x4*)(x + (size_t)m * DM) + F.lane; const f32x4* gr = (const f32x4*)g + F.lane;
        f32x4 v[8]; float ss = 0.f;
#pragma unroll
        for (int j = 0; j < 8; ++j) { v[j] = xr[64 * j]; ss += (v[j].x * v[j].x + v[j].y * v[j].y) + (v[j].z * v[j].z + v[j].w * v[j].w); }
        const float rs = 1.0f / sqrtf(wave_sum(ss, F.lane) * (1.0f / DM) + EPS);
        u32x2* o8 = (u32x2*)(XN + (size_t)m * DM) + F.lane;
        float lg[NE];
        if (ROUTER) {
#pragma unroll
            for (int e = 0; e < NE; ++e) lg[e] = 0.f; }
#pragma unroll
        for (int j = 0; j < 8; ++j) { const f32x4 gg = gr[64 * j]; const f32x4 y = v[j] * rs * gg;
            if (XN) o8[64 * j] = (u32x2){pk2(y.x, y.y), pk2(y.z, y.w)};
            if (XN8) ((unsigned*)(XN8 + (size_t)m * DM))[F.lane + 64 * j] = pg8::cvt_pk4_fp8(__builtin_amdgcn_fmed3f(y.x, -448.f, 448.f), __builtin_amdgcn_fmed3f(y.y, -448.f, 448.f), __builtin_amdgcn_fmed3f(y.z, -448.f, 448.f), __builtin_amdgcn_fmed3f(y.w, -448.f, 448.f));
            if (ROUTER) { const f32x4* rp = (const f32x4*)(R + (size_t)(4 * (F.lane + 64 * j)) * NE);
#pragma unroll
                for (int q = 0; q < 4; ++q) { const f32x4 r0 = rp[2 * q], r1 = rp[2 * q + 1]; const float yy = y[q];
                    lg[0] += yy * r0.x; lg[1] += yy * r0.y; lg[2] += yy * r0.z; lg[3] += yy * r0.w; lg[4] += yy * r1.x; lg[5] += yy * r1.y; lg[6] += yy * r1.z; lg[7] += yy * r1.w; } } }
        if (ROUTER) {
#pragma unroll
            for (int e = 0; e < NE; ++e) lg[e] = wave_sum(lg[e], F.lane);
            int e0 = 0; float v0 = lg[0];
#pragma unroll
            for (int e = 1; e < NE; ++e) if (lg[e] > v0) { v0 = lg[e]; e0 = e; }
            int e1 = -1; float v1 = -3.0e38f;
#pragma unroll
            for (int e = 0; e < NE; ++e) if (e != e0 && lg[e] > v1) { v1 = lg[e]; e1 = e; }
            const float ex = expf(v1 - v0), w0 = 1.0f / (1.0f + ex), w1 = ex / (1.0f + ex);
            if (F.lane == 0) { route[m] = (u32x4){(unsigned)e0, (unsigned)e1, __float_as_uint(w0), __float_as_uint(w1)};
                __hip_atomic_fetch_add((LAS unsigned*)lcnt + e0, 1u, __ATOMIC_RELAXED, __HIP_MEMORY_SCOPE_WORKGROUP);
                __hip_atomic_fetch_add((LAS unsigned*)lcnt + e1, 1u, __ATOMIC_RELAXED, __HIP_MEMORY_SCOPE_WORKGROUP); } }
    }
    if (ROUTER) { __syncthreads(); if (F.tid < NE) __hip_atomic_fetch_add(cnt + F.tid, lcnt[F.tid], __ATOMIC_RELAXED, __HIP_MEMORY_SCOPE_AGENT); __syncthreads(); }
}

__device__ __forceinline__ void ph_prep(const Frame& F, bf16* PROJ, const int* pos, const float* convw  , const float* qn, const float* kn) {
    const int gw = F.bx * NWAVES + F.wave, NGW = F.G * NWAVES, lane = F.lane;
    const int c0 = lane * 16;
    for (int m = gw; m < T; m += NGW) {
        bf16* P = PROJ + (size_t)m * LD; const int t = m & (SEQ - 1);
        u32x4 cc[3][2], cu[3][2];
#pragma unroll
        for (int j = 0; j < 3; ++j) { const int dt = 2 - j; const bf16* Pj = P - (size_t)(t - dt >= 0 ? dt : 0) * LD;
            cc[j][0] = *(const u32x4*)(Pj + C_CC + c0); cc[j][1] = *(const u32x4*)(Pj + C_CC + c0 + 8); cu[j][0] = *(const u32x4*)(Pj + C_CU + c0); cu[j][1] = *(const u32x4*)(Pj + C_CU + c0 + 8); }
        const u32x4 ba = *(const u32x4*)(P + C_CB + c0), bb = *(const u32x4*)(P + C_CB + c0 + 8);
        asm volatile("" ::: "memory");
        { float accv[16];
#pragma unroll
          for (int e = 0; e < 16; ++e) accv[e] = 0.f;
#pragma unroll
          for (int j = 0; j < 3; ++j) { const float on = (t - (2 - j) >= 0) ? 1.0f : 0.0f; const float* w = convw + j * MIXW + c0;
              const unsigned cw[8] = {cc[j][0].x, cc[j][0].y, cc[j][0].z, cc[j][0].w, cc[j][1].x, cc[j][1].y, cc[j][1].z, cc[j][1].w};
              const unsigned uw[8] = {cu[j][0].x, cu[j][0].y, cu[j][0].z, cu[j][0].w, cu[j][1].x, cu[j][1].y, cu[j][1].z, cu[j][1].w};
#pragma unroll
              for (int e = 0; e < 8; ++e) { accv[2 * e] += on * w[2 * e] * (bflo(cw[e]) * bflo(uw[e])); accv[2 * e + 1] += on * w[2 * e + 1] * (bfhi(cw[e]) * bfhi(uw[e])); } }
          const unsigned bw[8] = {ba.x, ba.y, ba.z, ba.w, bb.x, bb.y, bb.z, bb.w};
          unsigned ow[8];
#pragma unroll
          for (int e = 0; e < 8; ++e) ow[e] = pk2(bflo(bw[e]) * accv[2 * e], bfhi(bw[e]) * accv[2 * e + 1]);
          *(u32x4*)(P + C_CB + c0) = (u32x4){ow[0], ow[1], ow[2], ow[3]}; *(u32x4*)(P + C_CB + c0 + 8) = (u32x4){ow[4], ow[5], ow[6], ow[7]}; }
    }
}

__device__ __forceinline__ size_t sc_off(int b, int i) { return (size_t)b * SCB + (size_t)16384 * ((size_t)i * (i + 1) / 2); }
#define RELU(x) __builtin_amdgcn_fmed3f((x), 0.f, 3.0e38f)
struct IdxPos { int b, i, jj; };
__device__ __forceinline__ IdxPos idx_decode(int t) { IdxPos p; p.b = t / 4160; const int r = t - p.b * 4160;
    int i = (int)((sqrtf(4.0f * (float)r + 1.0f) - 1.0f) * 0.5f); while ((i + 1) * (i + 2) <= r) ++i; while (i * (i + 1) > r) --i; p.i = i; p.jj = r - i * (i + 1); return p; }
__device__ __forceinline__ void ph_scores(const Frame& F, const bf16* PROJ, unsigned short* SC  ) {
    const int NTILE = 2 * 4160; const int lo = (int)((long)F.bx * NTILE / F.G), hi = (int)((long)(F.bx + 1) * NTILE / F.G);
    if (lo >= hi) return;
    const int lane = F.lane, r32 = lane & 31, h2 = lane >> 5;
    IdxPos cur = idx_decode(lo);
    bf16x8 Af[4][4]; float w[4][4][4]; bf16x8 B0[2][4], B1[2][4];
#define IDX_LOADA(P_) do { const int m0_ = (P_).b * SEQ + (P_).i * 128 + F.wave * 16; \
        _Pragma("unroll") for (int rb = 0; rb < 4; ++rb) { \
            _Pragma("unroll") for (int ks = 0; ks < 4; ++ks) Af[rb][ks] = *(const bf16x8*)(PROJ + (size_t)(m0_ + 4 * rb + (r32 >> 3)) * LD + C_IQ + (r32 & 7) * 64 + 16 * ks + 8 * h2); \
            _Pragma("unroll") for (int tt = 0; tt < 4; ++tt) { const u32x2 ww = *(const u32x2*)(PROJ + (size_t)(m0_ + 4 * rb + tt) * LD + C_IW + 4 * h2); \
                w[rb][tt][0] = bflo(ww.x) * 0.04419417382415922f; w[rb][tt][1] = bfhi(ww.x) * 0.04419417382415922f; w[rb][tt][2] = bflo(ww.y) * 0.04419417382415922f; w[rb][tt][3] = bfhi(ww.y) * 0.04419417382415922f; } } } while (0)
#define IDX_LOADB(BX, P_) do { const int s0_ = (P_).b * SEQ + (P_).jj * 64; \
        _Pragma("unroll") for (int cb = 0; cb < 2; ++cb) _Pragma("unroll") for (int ks = 0; ks < 4; ++ks) BX[cb][ks] = *(const bf16x8*)(PROJ + (size_t)(s0_ + 32 * cb + r32) * LD + C_IK + 16 * ks + 8 * h2); } while (0)
#define IDX_COMPUTE(BX, P_) do { unsigned short* srow_ = SC + sc_off((P_).b, (P_).i) + (P_).jj * 64 + r32; const int rs_ = 128 * ((P_).i + 1); \
        _Pragma("unroll") for (int rb = 0; rb < 4; ++rb) _Pragma("unroll") for (int cb = 0; cb < 2; ++cb) { f32x16 d = {}; \
            _Pragma("unroll") for (int ks = 0; ks < 4; ++ks) d = __builtin_amdgcn_mfma_f32_32x32x16_bf16(Af[rb][ks], BX[cb][ks], d, 0, 0, 0); \
            float v[4]; \
            _Pragma("unroll") for (int tt = 0; tt < 4; ++tt) { v[tt] = w[rb][tt][0] * RELU(d[4 * tt]) + w[rb][tt][1] * RELU(d[4 * tt + 1]) + w[rb][tt][2] * RELU(d[4 * tt + 2]) + w[rb][tt][3] * RELU(d[4 * tt + 3]); \
                { const auto sw_ = __builtin_amdgcn_permlane32_swap(__float_as_uint(v[tt]), __float_as_uint(v[tt]), false, false); v[tt] = __uint_as_float(sw_[0]) + __uint_as_float(sw_[1]); } } \
            const float s0v = h2 ? v[2] : v[0], s1v = h2 ? v[3] : v[1]; const int tl = F.wave * 16 + 4 * rb + 2 * h2; \
            srow_[(size_t)tl * rs_ + 32 * cb] = __builtin_bit_cast(unsigned short, (_Float16)s0v); srow_[(size_t)(tl + 1) * rs_ + 32 * cb] = __builtin_bit_cast(unsigned short, (_Float16)s1v); } } while (0)
    IDX_LOADA(cur); IDX_LOADB(B0, cur);
    int t = lo;
#pragma unroll 1
    for (;;) {
        { IdxPos nx = cur; ++nx.jj; if (nx.jj == 2 * (nx.i + 1)) { nx.jj = 0; ++nx.i; if (nx.i == 64) { nx.i = 0; ++nx.b; } }
          const bool more = t + 1 < hi; if (more) IDX_LOADB(B1, nx);
          IDX_COMPUTE(B0, cur); if (!more) break;
          if (nx.jj == 0) IDX_LOADA(nx);
          cur = nx; ++t; }
        { IdxPos nx = cur; ++nx.jj; if (nx.jj == 2 * (nx.i + 1)) { nx.jj = 0; ++nx.i; if (nx.i == 64) { nx.i = 0; ++nx.b; } }
          const bool more = t + 1 < hi; if (more) IDX_LOADB(B0, nx);
          IDX_COMPUTE(B1, cur); if (!more) break;
          if (nx.jj == 0) IDX_LOADA(nx);
          cur = nx; ++t; }
    }
#undef IDX_LOADA
#undef IDX_LOADB
#undef IDX_COMPUTE
}

__device__ __forceinline__ unsigned f2key(float f) { const unsigned u = __float_as_uint(f); return u ^ ((u >> 31) ? 0xffffffffu : 0x80000000u); }
__device__ __forceinline__ int wave_sum_i(int v, int lane) { (void)lane; v = row16_sum_i(v);
    return (__builtin_amdgcn_readlane(v, 0) + __builtin_amdgcn_readlane(v, 16)) + (__builtin_amdgcn_readlane(v, 32) + __builtin_amdgcn_readlane(v, 48)); }
#define SEL_GROUPS(BODY) do { { constexpr int g = 0; BODY } if (ng > 1) { constexpr int g = 1; BODY } if (ng > 2) { constexpr int g = 2; BODY } if (ng > 3) { constexpr int g = 3; BODY } } while (0)
__device__ __forceinline__ void select_row(const unsigned short* srow, int t, u64* mcol  , int lane, LAS unsigned* scr  , const CvmLane& CL) {
    unsigned key[128];
    const int ng = (t >> 11) + 1;
    int ln = lane; asm volatile("" : "+v"(ln));
    SEL_GROUPS({ unsigned f[32];
        _Pragma("unroll") for (int q = 0; q < 32; ++q) f[q] = srow[64 * (32 * g + q) + ln];
        _Pragma("unroll") for (int q = 0; q < 32; ++q) { const int s_ = 64 * (32 * g + q) + ln; key[32 * g + q] = (f[q] ^ ((f[q] >> 15) ? 0xffffu : 0x8000u)) & ~(unsigned)((t - s_) >> 31); } });
    f32x4 cv[8]; cvm_load<0>(CL, cv);
    const int ntot = 2048 * ng;
    unsigned prefix = 0u; int c_lo = ntot, c_up = 0, bit = 15;
#pragma unroll 1
    for (; bit >= 0; --bit) {
        if (c_lo - c_up <= 64) break;
        const unsigned cand = prefix | (1u << bit); unsigned a0 = 0u, a1 = 0u;
        SEL_GROUPS({ _Pragma("unroll") for (int q = 0; q < 32; q += 2) { a0 += (key[32 * g + q] - cand) >> 31; a1 += (key[32 * g + q + 1] - cand) >> 31; } });
        const int c = ntot - wave_sum_i((int)(a0 + a1), lane);
        if (c >= 256) { prefix = cand; c_lo = c; } else c_up = c;
    }
    cvm_store<0>(CL, cv); cvm_load<1>(CL, cv);
    unsigned ck = 0u;
    if (bit >= 0) {
        const unsigned sh = (unsigned)bit + 1u, pfx = prefix >> sh; int run = 0;
        SEL_GROUPS({ _Pragma("unroll") for (int q = 0; q < 32; ++q) { const unsigned kk = key[32 * g + q]; const bool inb = (kk >> sh) == pfx; const u64 m = __ballot(inb);
            const int pos = run + (int)__builtin_amdgcn_mbcnt_hi((unsigned)(m >> 32), __builtin_amdgcn_mbcnt_lo((unsigned)m, 0u));
            if (inb) scr[pos & 63] = kk;
            run += __builtin_popcountll(m); __builtin_amdgcn_sched_barrier(0); } });
        ck = (lane < run) ? scr[lane] : 0u;
#pragma unroll 1
        for (; bit >= 0; --bit) { const unsigned cand = prefix | (1u << bit); const int c = c_up + __builtin_popcountll(__ballot(ck >= cand)); if (c >= 256) { prefix = cand; c_lo = c; } }
    }
    int cgt;
    { const unsigned cand = prefix + 1u; unsigned a0 = 0u, a1 = 0u;
      SEL_GROUPS({ _Pragma("unroll") for (int q = 0; q < 32; q += 2) { a0 += (key[32 * g + q] - cand) >> 31; a1 += (key[32 * g + q + 1] - cand) >> 31; } });
      cgt = ntot - wave_sum_i((int)(a0 + a1), lane); }
    const int need = 256 - cgt; unsigned w0l = 0u, w0h = 0u, w1l = 0u, w1h = 0u;
    unsigned pf = prefix; asm volatile("" : "+v"(pf));
#define SEL_PUT(b_, j_) do { const unsigned bl_ = (unsigned)(b_), bh_ = (unsigned)((b_) >> 32); \
        if ((j_) < 64) { asm volatile("s_nop 1\n\tv_writelane_b32 %0, %1, %2" : "+v"(w0l) : "s"(bl_), "n"((j_) & 63)); asm volatile("s_nop 1\n\tv_writelane_b32 %0, %1, %2" : "+v"(w0h) : "s"(bh_), "n"((j_) & 63)); } \
        else { asm volatile("s_nop 1\n\tv_writelane_b32 %0, %1, %2" : "+v"(w1l) : "s"(bl_), "n"((j_) & 63)); asm volatile("s_nop 1\n\tv_writelane_b32 %0, %1, %2" : "+v"(w1h) : "s"(bh_), "n"((j_) & 63)); } } while (0)
    if (c_lo - cgt == need) {
        SEL_GROUPS({ _Pragma("unroll") for (int q = 0; q < 32; ++q) { const u64 b = __ballot(key[32 * g + q] >= pf); SEL_PUT(b, 32 * g + q); __builtin_amdgcn_sched_barrier(0); } });
    } else { int run = 0;
        SEL_GROUPS({ _Pragma("unroll") for (int q = 0; q < 32; ++q) { const unsigned kk = key[32 * g + q]; const u64 beq = __ballot(kk == pf);
            const int below = (int)__builtin_amdgcn_mbcnt_hi((unsigned)(beq >> 32), __builtin_amdgcn_mbcnt_lo((unsigned)beq, 0u));
            const bool sel = (kk > pf) || (kk == pf && run + below < need);
            const u64 b = __ballot(sel); run += __builtin_popcountll(beq); SEL_PUT(b, 32 * g + q); __builtin_amdgcn_sched_barrier(0); } }); }
#undef SEL_PUT
    mcol[(size_t)lane * SEQ] = ((u64)w0h << 32) | w0l; mcol[(size_t)(lane + 64) * SEQ] = ((u64)w1h << 32) | w1l;
    cvm_store<1>(CL, cv);
}
__device__ __forceinline__ void ph_select(const Frame& F, const unsigned short* SC, u64* MASK, const CvmCtx& cc, int cvbase) {
    const int gw = F.bx * NWAVES + F.wave, NGW = F.G * NWAVES, lane = F.lane;
    for (int m = gw; m < T; m += NGW) { const int b = m >> 13, t = m & (SEQ - 1), i = t >> 7, nch = 2 * (i + 1);
        u64* mcol = MASK + (size_t)b * 128 * SEQ + t; const CvmLane CL = cvm_lane(cc, cvbase + CVM_SEL + m, lane);
        if (t < 256) {
            u64 w[2];
#pragma unroll
            for (int q = 0; q < 2; ++q) { const int j = lane + 64 * q; const int rem = t - 64 * j + 1;
                w[q] = rem <= 0 ? 0ull : (rem >= 64 ? ~0ull : ((1ull << rem) - 1ull)); }
            mcol[(size_t)lane * SEQ] = w[0]; mcol[(size_t)(lane + 64) * SEQ] = w[1];
            f32x4 v0[8], v1[8]; cvm_load<0>(CL, v0); cvm_load<1>(CL, v1); cvm_store<0>(CL, v0); cvm_store<1>(CL, v1);
        } else {
            const unsigned short* srow = SC + sc_off(b, i) + (size_t)(t & 127) * (128 * (i + 1));
            LAS unsigned* scr = (LAS unsigned*)(F.lds + F.wave * 256);
            select_row(srow, t, mcol, lane, scr, CL);
        } }
}

constexpr int TRS = 272;
typedef short v4i16_t __attribute__((ext_vector_type(4)));
__device__ __forceinline__ s16x4 ldtr(LAS const unsigned char* p) { return __builtin_bit_cast(s16x4, __builtin_amdgcn_ds_read_tr16_b64_v4i16((LAS v4i16_t*)p)); }
__device__ __forceinline__ bf16x8 cat8(s16x4 a, s16x4 b) { return (bf16x8){a[0], a[1], a[2], a[3], b[0], b[1], b[2], b[3]}; }
template <bool SCALE>
__device__ __forceinline__ void stage_tile(LAS unsigned char* tile, const bf16* g, int tid, float lg) {
    const int row = tid >> 2, cq = (tid & 3) * 32; const bf16* p = g + (size_t)row * LD + cq;
    u32x4 v[4];
#pragma unroll
    for (int i = 0; i < 4; ++i) v[i] = *(const u32x4*)(p + 8 * i);
    if (SCALE) { const float sc = fast_exp2((float)(127 - row) * lg);
#pragma unroll
        for (int i = 0; i < 4; ++i) { v[i].x = pk2(bflo(v[i].x) * sc, bfhi(v[i].x) * sc); v[i].y = pk2(bflo(v[i].y) * sc, bfhi(v[i].y) * sc);
            v[i].z = pk2(bflo(v[i].z) * sc, bfhi(v[i].z) * sc); v[i].w = pk2(bflo(v[i].w) * sc, bfhi(v[i].w) * sc); } }
#pragma unroll
    for (int i = 0; i < 4; ++i) *(LAS u32x4*)(tile + row * TRS + (cq + 8 * i) * 2) = v[i];
}
__device__ __forceinline__ void kv_unit(const Frame& F, const bf16* PROJ, float* KVS, int u, const CvmCtx& cc, int cvbase) {
    const CvmLane CL = cvm_lane(cc, cvbase + CVM_KV + u * NWAVES + F.wave, F.lane); f32x4 cv0[8], cv1[8];
    const int h = u & 7, bn = u >> 3, m0 = bn * 128;
    const float lg = log2gamma(h);
    LAS unsigned char* Vt = F.lds, * Kt = F.lds + 128 * TRS;
    stage_tile<false>(Vt, PROJ + (size_t)m0 * LD + C_RV + h * DH, F.tid, 0.f);
    stage_tile<true>(Kt, PROJ + (size_t)m0 * LD + C_RK + h * DH, F.tid, lg);
    cvm_load<0>(CL, cv0); cvm_load<1>(CL, cv1);
    asm volatile("s_waitcnt lgkmcnt(0)\n\ts_barrier" ::: "memory");
    const int lane = F.lane, i16 = lane & 15, g = lane >> 4, qq = i16 >> 2, p4 = (i16 & 3) * 4, w = F.wave;
    f32x4 acc[8];
#pragma unroll
    for (int dt = 0; dt < 8; ++dt) acc[dt] = (f32x4){0.f, 0.f, 0.f, 0.f};
#pragma unroll
    for (int s = 0; s < 4; ++s) {
        const int r0 = 32 * s + 8 * g + qq;
        const bf16x8 af = cat8(ldtr(Vt + r0 * TRS + (16 * w + p4) * 2), ldtr(Vt + (r0 + 4) * TRS + (16 * w + p4) * 2));
#pragma unroll
        for (int dt = 0; dt < 8; ++dt) { const bf16x8 bfr = cat8(ldtr(Kt + r0 * TRS + (16 * dt + p4) * 2), ldtr(Kt + (r0 + 4) * TRS + (16 * dt + p4) * 2));
            acc[dt] = __builtin_amdgcn_mfma_f32_16x16x32_bf16(af, bfr, acc[dt], 0, 0, 0); } }
    float* out = KVS + (size_t)u * 16384;
#pragma unroll
    for (int dt = 0; dt < 8; ++dt)
#pragma unroll
        for (int r = 0; r < 4; ++r) out[(16 * w + 4 * g + r) * 128 + 16 * dt + i16] = acc[dt][r];
    cvm_store<0>(CL, cv0); cvm_store<1>(CL, cv1);
    asm volatile("s_waitcnt lgkmcnt(0)\n\ts_barrier" ::: "memory");
}
__device__ __forceinline__ void ph_scan(const Frame& F, float* KVS) {
    const int gt = F.bx * NTHREADS + F.tid, NGT = F.G * NTHREADS;
    for (int c = gt; c < NB * NH * 16384; c += NGT) { const int bh = c >> 14, ed = c & 16383, b = bh >> 3, h = bh & 7;
        const float cd = exp2f(128.0f * log2gamma(h)); float* p = KVS + ((size_t)(b * 64) * 8 + h) * 16384 + ed; float s = 0.f;
#pragma unroll 1
        for (int n0 = 0; n0 < 64; n0 += 16) { float v[16];
#pragma unroll
            for (int q = 0; q < 16; ++q) v[q] = p[(size_t)(n0 + q) * 8 * 16384];
#pragma unroll
            for (int q = 0; q < 16; ++q) { p[(size_t)(n0 + q) * 8 * 16384] = s; s = s * cd + v[q]; } } }
}
__device__ __forceinline__ void ret_unit(const Frame& F, bf16* PROJ, const float* KVS, const float* gnw, const float* gnb, int u, const CvmCtx& cc, int cvbase) {
    const CvmLane CL = cvm_lane(cc, cvbase + CVM_RET + u * NWAVES + F.wave, F.lane); f32x4 cv0[8], cv1[8];
    const int h = u & 7, bn = u >> 3, m0 = bn * 128; const float lg = log2gamma(h);
    LAS unsigned char* Kt = F.lds, * Vt = F.lds + 128 * TRS, * Pt = F.lds + 2 * 128 * TRS;
    stage_tile<false>(Kt, PROJ + (size_t)m0 * LD + C_RK + h * DH, F.tid, 0.f);
    stage_tile<false>(Vt, PROJ + (size_t)m0 * LD + C_RV + h * DH, F.tid, 0.f);
    { const int row = F.tid >> 2, cq = (F.tid & 3) * 32; const float* p = KVS + (size_t)u * 16384 + row * 128 + cq;
#pragma unroll
      for (int i = 0; i < 4; ++i) { const f32x4 a = *(const f32x4*)(p + 8 * i), b2 = *(const f32x4*)(p + 8 * i + 4);
          *(LAS u32x4*)(Pt + row * TRS + (cq + 8 * i) * 2) = (u32x4){pk2(a.x, a.y), pk2(a.z, a.w), pk2(b2.x, b2.y), pk2(b2.z, b2.w)}; } }
    cvm_load<0>(CL, cv0); cvm_load<1>(CL, cv1);
    asm volatile("s_waitcnt lgkmcnt(0)\n\ts_barrier" ::: "memory");
    const int lane = F.lane, i16 = lane & 15, g = lane >> 4, qq = i16 >> 2, p4 = (i16 & 3) * 4, w = F.wave;
    const int tl = 16 * w + i16;
    bf16x8 qf[4];
#pragma unroll
    for (int ks = 0; ks < 4; ++ks) qf[ks] = *(const bf16x8*)(PROJ + (size_t)(m0 + tl) * LD + C_RQ + h * DH + 32 * ks + 8 * g);
    bf16x8 sb[4];
#pragma unroll
    for (int s = 0; s < 4; ++s) { unsigned pw[4];
#pragma unroll
        for (int hlf = 0; hlf < 2; ++hlf) { const int jt = 2 * s + hlf; f32x4 st = {0.f, 0.f, 0.f, 0.f};
            if (jt <= w) {
#pragma unroll
                for (int ks = 0; ks < 4; ++ks) { const bf16x8 ka = *(LAS const bf16x8*)(Kt + (16 * jt + i16) * TRS + (32 * ks + 8 * g) * 2);
                    st = __builtin_amdgcn_mfma_f32_16x16x32_bf16(ka, qf[ks], st, 0, 0, 0); }
#pragma unroll
                for (int r = 0; r < 4; ++r) { const int dj = tl - (16 * jt + 4 * g + r); st[r] = dj >= 0 ? st[r] * fast_exp2((float)dj * lg) : 0.f; } }
            pw[2 * hlf] = pk2(st[0], st[1]); pw[2 * hlf + 1] = pk2(st[2], st[3]); }
        sb[s] = __builtin_bit_cast(bf16x8, (u32x4){pw[0], pw[1], pw[2], pw[3]}); }
    const float qdec = fast_exp2((float)(tl + 1) * lg);
    f32x4 o[8]; float sum = 0.f;
#pragma unroll
    for (int et = 0; et < 8; ++et) { f32x4 ai = {0.f, 0.f, 0.f, 0.f}, ac = {0.f, 0.f, 0.f, 0.f};
#pragma unroll
        for (int s = 0; s < 4; ++s) { if (2 * s <= w) { const int r0 = 32 * s + 4 * g + qq;
                const bf16x8 va = cat8(ldtr(Vt + r0 * TRS + (16 * et + p4) * 2), ldtr(Vt + (r0 + 16) * TRS + (16 * et + p4) * 2));
                ai = __builtin_amdgcn_mfma_f32_16x16x32_bf16(va, sb[s], ai, 0, 0, 0); } }
#pragma unroll
        for (int ks = 0; ks < 4; ++ks) { const bf16x8 pa = *(LAS const bf16x8*)(Pt + (16 * et + i16) * TRS + (32 * ks + 8 * g) * 2);
            ac = __builtin_amdgcn_mfma_f32_16x16x32_bf16(pa, qf[ks], ac, 0, 0, 0); }
        o[et] = ai + ac * qdec; sum += (o[et][0] + o[et][1]) + (o[et][2] + o[et][3]); }
    sum += xshf(sum, 16, lane); sum += xshf(sum, 32, lane);
    const float mean = sum * (1.0f / DH); float var = 0.f;
#pragma unroll
    for (int et = 0; et < 8; ++et)
#pragma unroll
        for (int r = 0; r < 4; ++r) { const float dlt = o[et][r] - mean; var += dlt * dlt; }
    var += xshf(var, 16, lane); var += xshf(var, 32, lane);
    const float rstd = 1.0f / sqrtf(var * (1.0f / DH) + EPS);
    bf16* yrow = PROJ + (size_t)(m0 + tl) * LD + C_RG + h * DH;
    u32x2 rgall[8];
#pragma unroll
    for (int et = 0; et < 8; ++et) rgall[et] = *(const u32x2*)(yrow + 16 * et + 4 * g);
    asm volatile("" ::: "memory");
#pragma unroll
    for (int et = 0; et < 8; ++et) { const int e0 = 16 * et + 4 * g; const u32x2 rgw = rgall[et];
        const f32x4 gw4 = *(const f32x4*)(gnw + h * DH + e0), gb4 = *(const f32x4*)(gnb + h * DH + e0);
        const float rg[4] = {bflo(rgw.x), bfhi(rgw.x), bflo(rgw.y), bfhi(rgw.y)}; float y[4];
#pragma unroll
        for (int r = 0; r < 4; ++r) { const float nv = (o[et][r] - mean) * rstd * gw4[r] + gb4[r]; y[r] = rg[r] * sigmoidf_(rg[r]) * nv; }
        *(u32x2*)(yrow + e0) = (u32x2){pk2(y[0], y[1]), pk2(y[2], y[3])}; }
    cvm_store<0>(CL, cv0); cvm_store<1>(CL, cv1);
    asm volatile("s_waitcnt lgkmcnt(0)\n\ts_barrier" ::: "memory");
}

constexpr int SHM_K = 64 * 128 * 2, SHM_V = 64 * 128 * 2;
#define KSWZ(row, colB) ((row) * 256 + ((colB) ^ (((row) & 7) << 4)))
__device__ __forceinline__ int v_st(int k, int c) { const int kk = (k & ~0xC) | ((k & 4) << 1) | ((k & 8) >> 1); return ((kk >> 3) * 4 + (c >> 5)) * 512 + ((kk & 7) * 32 + (c & 31)) * 2; }
__device__ __forceinline__ int v_rd_base(int lane) { return ((lane & 3) << 3) | (((lane >> 2) & 3) << 6) | (((lane >> 4) & 1) << 5) | (((lane >> 5) & 1) << 8); }
constexpr int v_rd_off(int d0, int ks, int half) { return d0 * 512 + ks * 4096 + half * 2048; }
__device__ __forceinline__ int crow(int r, int hi) { return (r & 3) + 8 * (r >> 2) + 4 * hi; }
#define SBAR() __builtin_amdgcn_sched_barrier(0)
template <int KB>
__device__ __forceinline__ void qkt(f32x16& p0, f32x16& p1, LAS const unsigned char* K_lds, int r32, int hi, const bf16x8* qr) {
    LAS const unsigned char* kb[4];
#pragma unroll
    for (int dd = 0; dd < 4; ++dd) kb[dd] = K_lds + KB * SHM_K + KSWZ(r32, (dd * 16 + hi * 8) * 2);
#pragma unroll
    for (int d0 = 0; d0 < 8; ++d0) { LAS const unsigned char* a = kb[d0 & 3] + (d0 >> 2) * 128;
        const bf16x8 b0 = *(LAS const bf16x8*)a, b1 = *(LAS const bf16x8*)(a + 32 * 256);
        p0 = __builtin_amdgcn_mfma_f32_32x32x16_bf16(b0, qr[d0], p0, 0, 0, 0);
        p1 = __builtin_amdgcn_mfma_f32_32x32x16_bf16(b1, qr[d0], p1, 0, 0, 0); }
}
__device__ __forceinline__ void pv_tile(f32x16* o, int vb0  , bf16x8 pa0, bf16x8 pa1, bf16x8 pa2, bf16x8 pa3) {
#define TRRD(dst, off) asm volatile("ds_read_b64_tr_b16 %0, %1 offset:%2" : "=&v"(dst) : "v"(vb0), "i"(off) : "memory")
#define PV_D0(d0) do { s16x4 l0, l1, l2, l3, h0, h1, h2, h3; constexpr int b_ = v_rd_off(d0, 0, 0); \
        TRRD(l0, b_); TRRD(h0, b_ + 2048); TRRD(l1, b_ + 4096); TRRD(h1, b_ + 6144); TRRD(l2, b_ + 8192); TRRD(h2, b_ + 10240); TRRD(l3, b_ + 12288); TRRD(h3, b_ + 14336); \
        asm volatile("s_waitcnt lgkmcnt(0)" ::: "memory"); SBAR();   \
        o[d0] = __builtin_amdgcn_mfma_f32_32x32x16_bf16(pa0, (bf16x8){l0[0], l0[1], l0[2], l0[3], h0[0], h0[1], h0[2], h0[3]}, o[d0], 0, 0, 0);   \
        o[d0] = __builtin_amdgcn_mfma_f32_32x32x16_bf16(pa1, (bf16x8){l1[0], l1[1], l1[2], l1[3], h1[0], h1[1], h1[2], h1[3]}, o[d0], 0, 0, 0);   \
        o[d0] = __builtin_amdgcn_mfma_f32_32x32x16_bf16(pa2, (bf16x8){l2[0], l2[1], l2[2], l2[3], h2[0], h2[1], h2[2], h2[3]}, o[d0], 0, 0, 0);   \
        o[d0] = __builtin_amdgcn_mfma_f32_32x32x16_bf16(pa3, (bf16x8){l3[0], l3[1], l3[2], l3[3], h3[0], h3[1], h3[2], h3[3]}, o[d0], 0, 0, 0); } while (0)
    PV_D0(0); PV_D0(1); PV_D0(2); PV_D0(3);
#undef PV_D0
#undef TRRD
}
struct AttnCtx { bf16* PROJ; const u64* MASK; const int* pos; const int* posmin; const int* posmax; const float* btab; float M2; };
__device__ __forceinline__ int bfe1(unsigned w, int pos) { int m; asm("v_bfe_i32 %0, %1, %2, 1" : "=v"(m) : "v"(w), "n"(pos)); return m; }
__device__ __forceinline__ float bsel(int m, float a, float b) { return __int_as_float((m & __float_as_int(a)) | (~m & __float_as_int(b))); }
template <bool FAR>
__device__ __forceinline__ void p_init(f32x16& p0, f32x16& p1, u64 mw, int hi, float cfar, const float* tab, int qpos, const int* kpos  , float M2) {
    const unsigned wlo = (unsigned)mw >> (4 * hi), whi = (unsigned)(mw >> 32) >> (4 * hi); const float NEG = -1.0e30f;
#pragma unroll
    for (int r = 0; r < 16; ++r) { const int bp = (r & 3) + 8 * (r >> 2);
        float c0 = cfar, c1 = cfar;
        if (!FAR) { int d0 = qpos - kpos[bp + 4 * hi], d1 = qpos - kpos[bp + 4 * hi + 32]; d0 = d0 < 0 ? 0 : (d0 > 128 ? 128 : d0); d1 = d1 < 0 ? 0 : (d1 > 128 ? 128 : d1);
            c0 = tab[d0] - M2; c1 = tab[d1] - M2; }
        p0[r] = bsel(bfe1(wlo, bp), c0, NEG); p1[r] = bsel(bfe1(whi, bp), c1, NEG);
        if (!FAR && (r & 3) == 3) SBAR(); }
}
__device__ __forceinline__ float p_finish(f32x16& p0, f32x16& p1, bf16x8& pa0, bf16x8& pa1, bf16x8& pa2, bf16x8& pa3) {
    float ps = 0.f;
#pragma unroll
    for (int r = 0; r < 16; ++r) { p0[r] = fast_exp2(p0[r]); p1[r] = fast_exp2(p1[r]); ps += p0[r] + p1[r]; }
#define PK4(P, B_, OUT) do { unsigned a0 = pk2(P[B_+0], P[B_+1]), a1 = pk2(P[B_+2], P[B_+3]); unsigned b0 = pk2(P[B_+4], P[B_+5]), b1 = pk2(P[B_+6], P[B_+7]); \
        auto r0 = __builtin_amdgcn_permlane32_swap(a0, b0, false, false); auto r1 = __builtin_amdgcn_permlane32_swap(a1, b1, false, false); \
        u32x4 w = {r0[0], r1[0], r0[1], r1[1]}; OUT = __builtin_bit_cast(bf16x8, w); } while (0)
    PK4(p0, 0, pa0); PK4(p0, 8, pa1); PK4(p1, 0, pa2); PK4(p1, 8, pa3);
#undef PK4
    return ps;
}
__device__ __forceinline__ void attn_unit(const Frame& F, const AttnCtx& C, int b, int h, int qb, bool dry) {
    const int tid = F.tid, wid = F.wave, lane = F.lane, r32 = lane & 31, hi = lane >> 5;
    LAS unsigned char* V_lds = F.lds; LAS unsigned char* K_lds = F.lds + 3 * SHM_V;
    const bool late = wid >= 4;
    const int q0 = qb * 256 + wid * 32;
    const int mrow = b * SEQ + q0 + r32;
    bf16* Qp = C.PROJ + (size_t)mrow * LD + C_AQ + h * DH;
    bf16x8 qr[8];
#pragma unroll
    for (int d0 = 0; d0 < 8; ++d0) qr[d0] = *(const bf16x8*)(Qp + d0 * 16 + hi * 8);
    const int NT = 4 * (qb + 1);
    const bf16* Kg = C.PROJ + (size_t)(b * SEQ) * LD + C_AK + h * DH; const bf16* Vg = C.PROJ + (size_t)(b * SEQ) * LD + C_AV + h * DH;
    const u64* mk = C.MASK + (size_t)(b * 128) * SEQ + (q0 + r32);
    const int sr = tid >> 4, sc = (tid & 15) * 8, vst0 = v_st(sr, sc), vst1 = v_st(32 + sr, sc), kws = KSWZ(sr, sc * 2);
    const int vb0 = (int)(unsigned)(size_t)V_lds + v_rd_base(lane);
    const int qpos = C.pos[mrow]; const int qpmin = C.posmin[(b * SEQ + q0) >> 6];
    const float* tab = C.btab + h * BIAS_PITCH; const float cfar = tab[128] - C.M2;
    float l = 0.f; f32x16 o[4] = {};
    u32x4 sk0, sk1, sv0, sv1; u64 mw, mwn = 0ull; int pmx, pmxn = 0;
#define ALOAD(t_) do { const size_t kr_ = (size_t)((t_) * 64 + sr) * LD + sc; sk0 = *(const u32x4*)(Kg + kr_); sk1 = *(const u32x4*)(Kg + kr_ + (size_t)32 * LD); \
                       sv0 = *(const u32x4*)(Vg + kr_); sv1 = *(const u32x4*)(Vg + kr_ + (size_t)32 * LD); } while (0)
#define AWRITE(bf_) do { *(LAS u32x4*)(K_lds + (bf_) * SHM_K + kws) = sk0; *(LAS u32x4*)(K_lds + (bf_) * SHM_K + kws + 32 * 256) = sk1; \
                         *(LAS u32x4*)(V_lds + vs * SHM_V + vst0) = sv0; *(LAS u32x4*)(V_lds + vs * SHM_V + vst1) = sv1; } while (0)
#define ASTEP(t_, BF_) do { AWRITE(BF_); mw = mwn; pmx = pmxn; if ((t_) + 1 < NT) { ALOAD((t_) + 1); mwn = mk[(size_t)((t_) + 1) * SEQ]; pmxn = C.posmax[(b * SEQ + ((t_) + 1) * 64) >> 6]; } \
        asm volatile("s_waitcnt lgkmcnt(0)\n\ts_barrier" ::: "memory");     \
        if (late && actprev) pv_tile(o, vb0 + vprev * SHM_V, pa0, pa1, pa2, pa3);     \
        const bool act_ = (t_) * 64 <= q0 + 31;                             \
        if (act_) { f32x16 p0, p1; \
            const bool farb = (qpmin - pmx) >= 128;                         \
            if (farb) p_init<true>(p0, p1, mw, hi, cfar, tab, qpos, C.pos + b * SEQ + (t_) * 64, C.M2); \
            else p_init<false>(p0, p1, mw, hi, cfar, tab, qpos, C.pos + b * SEQ + (t_) * 64, C.M2); \
            qkt<BF_>(p0, p1, K_lds, r32, hi, qr); \
            l += p_finish(p0, p1, pa0, pa1, pa2, pa3); \
            SBAR(); if (!late) pv_tile(o, vb0 + vs * SHM_V, pa0, pa1, pa2, pa3); } \
        actprev = act_; vprev = vs; vs = vs == 2 ? 0 : vs + 1; } while (0)
    bf16x8 pa0, pa1, pa2, pa3; int vs = 0, vprev = 0; bool actprev = false;
    ALOAD(0); mwn = mk[0]; pmxn = C.posmax[(b * SEQ) >> 6];
#pragma unroll 1
    for (int t = 0; t < NT; t += 2) { ASTEP(t, 0); ASTEP(t + 1, 1); }
    if (late && actprev) pv_tile(o, vb0 + vprev * SHM_V, pa0, pa1, pa2, pa3);
#undef ASTEP
#undef AWRITE
#undef ALOAD
    l += xshf(l, 32, lane);
    const float linv = 1.0f / l;
    int r32o = r32, hio = hi; asm volatile("" : "+v"(r32o), "+v"(hio));
    bf16* Ow = C.PROJ + (size_t)(b * SEQ + q0) * LD + C_CC + h * DH + r32o;
#pragma unroll
    for (int r = 0; r < 16; ++r) { const int orow = crow(r, hio); const float rl = lshf(linv, orow, lane);
#pragma unroll
        for (int d0 = 0; d0 < 4; ++d0) { const float v = o[d0][r] * rl; const float vn = xshf(v, 1, lane);
            if ((r32o & 1) == 0 && !dry) *(unsigned*)(Ow + (size_t)orow * LD + d0 * 32) = pk2(v, vn); } }
    __syncthreads();
}

__device__ __forceinline__ void gains_to_lds(const Frame& F, const float* g) { ((LAS f32x4*)(F.lds + pg8::STAGE_BYTES))[F.tid] = ((const f32x4*)g)[F.tid]; __syncthreads(); }
__device__ __forceinline__ void rstd_table(const Frame& F, const float* SSQ) {
    LAS float* tab = (LAS float*)(F.lds + pg8::STAGE_BYTES); const int rb = (F.bx & 7) * 2048;
#pragma unroll 1
    for (int q = 0; q < 4; ++q) { const int r = F.tid + 512 * q; const f32x4* p = (const f32x4*)(SSQ + (size_t)(rb + r) * 32); f32x4 v[8];
#pragma unroll
        for (int i = 0; i < 8; ++i) v[i] = p[i];
        float sq = 0.f;
#pragma unroll
        for (int i = 0; i < 8; ++i) sq += (v[i].x + v[i].y) + (v[i].z + v[i].w);
        tab[r] = 1.0f / sqrtf(sq * (1.0f / DM) + EPS); }
    __syncthreads();
}
__device__ __forceinline__ void ph_assign(const Frame& F, const u32x4* route, const unsigned* cnt, unsigned* cur, int* tiles  , int* tokslot  , const unsigned char* XN8  , unsigned char* HPERM  ) {
    volatile LAS int* sh = (volatile LAS int*)F.lds;
    int seg[9]; seg[0] = 0;
#pragma unroll
    for (int e = 0; e < NE; ++e) { const unsigned c = __hip_atomic_load(cnt + e, __ATOMIC_RELAXED, __HIP_MEMORY_SCOPE_AGENT); seg[e + 1] = seg[e] + (int)((c + 255u) >> 8); }
    if (F.bx == 0 && F.tid < 9) { int v = 0;
#pragma unroll
        for (int e = 0; e < 9; ++e) v = (F.tid == e) ? seg[e] : v;
        tiles[F.tid] = v; }
    for (int ch = F.bx; ch < T / 64; ch += F.G) {
        if (F.tid < NE) sh[F.tid] = 0;
        __syncthreads();
        int e = 0, rank = 0; const int tok = ch * 64 + (F.tid >> 1), k = F.tid & 1;
        if (F.tid < 128) { const u32x4 r = route[tok]; e = (int)(k ? r.y : r.x); rank = __hip_atomic_fetch_add((LAS int*)sh + e, 1, __ATOMIC_RELAXED, __HIP_MEMORY_SCOPE_WORKGROUP); }
        __syncthreads();
        if (F.tid < NE) sh[8 + F.tid] = (int)__hip_atomic_fetch_add(cur + F.tid, (unsigned)sh[F.tid], __ATOMIC_RELAXED, __HIP_MEMORY_SCOPE_AGENT);
        __syncthreads();
        if (F.tid < 128) { int sg = 0;
#pragma unroll
            for (int q = 0; q < NE; ++q) sg = (e == q) ? seg[q] : sg;
            const int slot = sg * 256 + sh[8 + e] + rank; sh[32 + F.tid] = slot; tokslot[tok * 2 + k] = slot; }
        __syncthreads();
        for (int a2 = 0; a2 < 128; a2 += 16) { u32x2 v[8]; const int piece = F.tid & 255;
#pragma unroll
            for (int q = 0; q < 8; ++q) { const int a1 = a2 + 2 * q + (F.tid >> 8); v[q] = *(const u32x2*)(XN8 + (size_t)(ch * 64 + (a1 >> 1)) * DM + piece * 8); }
#pragma unroll
            for (int q = 0; q < 8; ++q) { const int a1 = a2 + 2 * q + (F.tid >> 8); *(u32x2*)(HPERM + (size_t)sh[32 + a1] * DM + piece * 8) = v[q]; } }
        __syncthreads();
    }
}
__device__ __forceinline__ void moe_row8(const bf16* Y, const bf16* PART, int slot, int cidx, int ntiles, int tail0  , int ks, float (&v)[8]) {
    const int pm = slot >> 8, pnl = cidx >> 5, gid = pm >> 3, fm = gid * 8, gsz = (ntiles - fm) < 8 ? (ntiles - fm) : 8, L = gid * 64 + pnl * gsz + (pm - fm);
    if (L < tail0) { const u32x4 a = *(const u32x4*)(Y + (size_t)slot * DM + cidx * 8);
        v[0] = bflo(a.x); v[1] = bfhi(a.x); v[2] = bflo(a.y); v[3] = bfhi(a.y); v[4] = bflo(a.z); v[5] = bfhi(a.z); v[6] = bflo(a.w); v[7] = bfhi(a.w); }
    else {
#pragma unroll
        for (int e = 0; e < 8; ++e) v[e] = 0.f;
        for (int kh = 0; kh < ks; ++kh) { const u32x4 a = *(const u32x4*)(PART + (size_t)((L - tail0) * ks + kh) * 65536 + (slot & 255) * 256 + (cidx & 31) * 8);
            v[0] += bflo(a.x); v[1] += bfhi(a.x); v[2] += bflo(a.y); v[3] += bfhi(a.y); v[4] += bflo(a.z); v[5] += bfhi(a.z); v[6] += bflo(a.w); v[7] += bfhi(a.w); } }
}
__device__ __forceinline__ void ph_combine(const Frame& F, float* out, const bf16* Y, const bf16* PART, const u32x4* route, const int* tokslot, const int* tiles) {
    const int gw = F.bx * NWAVES + F.wave, NGW = F.G * NWAVES;
    const int ntiles = __builtin_amdgcn_readfirstlane(tiles[8]), nwg = ntiles * 8, full = nwg / F.G, rem = nwg - full * F.G;
    const int ks = pg8::MoeOrder::tail_split(rem, F.G, DFFE / 2);
    const int tail0 = ks > 1 ? full * F.G : 0x7fffffff;
    for (int m = gw; m < T; m += NGW) { const u32x4 r = route[m]; const float w0 = __uint_as_float(r.z), w1 = __uint_as_float(r.w); const int s0 = tokslot[2 * m], s1 = tokslot[2 * m + 1];
        f32x4* o = (f32x4*)(out + (size_t)m * DM) + 2 * F.lane;
        const int pm0 = s0 >> 8, pm1 = s1 >> 8, f0 = (pm0 >> 3) * 8, f1 = (pm1 >> 3) * 8, g0 = (ntiles - f0) < 8 ? (ntiles - f0) : 8, g1 = (ntiles - f1) < 8 ? (ntiles - f1) : 8;
        if ((pm0 >> 3) * 64 + 7 * g0 + (pm0 - f0) < tail0 && (pm1 >> 3) * 64 + 7 * g1 + (pm1 - f1) < tail0) {
            const u32x4* y0 = (const u32x4*)(Y + (size_t)s0 * DM) + F.lane; const u32x4* y1 = (const u32x4*)(Y + (size_t)s1 * DM) + F.lane;
#pragma unroll
            for (int j = 0; j < 4; ++j) { const u32x4 a = y0[64 * j], b = y1[64 * j];
                const f32x4 lo = {bflo(a.x) * w0 + bflo(b.x) * w1, bfhi(a.x) * w0 + bfhi(b.x) * w1, bflo(a.y) * w0 + bflo(b.y) * w1, bfhi(a.y) * w0 + bfhi(b.y) * w1};
                const f32x4 hi = {bflo(a.z) * w0 + bflo(b.z) * w1, bfhi(a.z) * w0 + bfhi(b.z) * w1, bflo(a.w) * w0 + bflo(b.w) * w1, bfhi(a.w) * w0 + bfhi(b.w) * w1};
                o[128 * j] = o[128 * j] + lo; o[128 * j + 1] = o[128 * j + 1] + hi; }
            continue; }
#pragma unroll 1
        for (int j = 0; j < 4; ++j) { float a[8], b[8]; moe_row8(Y, PART, s0, F.lane + 64 * j, ntiles, tail0, ks, a); moe_row8(Y, PART, s1, F.lane + 64 * j, ntiles, tail0, ks, b);
            const f32x4 lo = {a[0] * w0 + b[0] * w1, a[1] * w0 + b[1] * w1, a[2] * w0 + b[2] * w1, a[3] * w0 + b[3] * w1};
            const f32x4 hi = {a[4] * w0 + b[4] * w1, a[5] * w0 + b[5] * w1, a[6] * w0 + b[6] * w1, a[7] * w0 + b[7] * w1};
            o[128 * j] = o[128 * j] + lo; o[128 * j + 1] = o[128 * j + 1] + hi; } }
}

#ifndef MK_CHECK
#define MK_CHECK 0
#endif
#if MK_CHECK
constexpr int CHK_NS = 64, CW_CHK = 8320; constexpr size_t MS_CHK = 1u << 20;
__device__ __forceinline__ int chk_token(int k) { const int b = k & 1, i = k >> 1;
    const int t = i < 8 ? i * 37 : (i < 16 ? 248 + (i - 8) * 2 : (i < 24 ? 2040 + (i - 16) * 3 : 8191 - (i - 24) * 601)); return b * SEQ + t; }
__device__ __forceinline__ void chk_ret_expected(const Frame& F, const bf16* PROJ, const float* gnw, const float* gnb, float* CHK) {
    if (F.bx >= CHK_NS) return;
    const int m = chk_token(F.bx), b = m >> 13, t = m & (SEQ - 1), h = F.wave, lane = F.lane; const float lg = log2gamma(h);
    const bf16* qp = PROJ + (size_t)m * LD + C_RQ + h * DH; const float q0 = bf2f(qp[lane]), q1 = bf2f(qp[lane + 64]); float o0 = 0.f, o1 = 0.f;
    for (int j = 0; j <= t; ++j) { const bf16* rp = PROJ + (size_t)(b * SEQ + j) * LD;
        const float dot = wave_sum(q0 * bf2f(rp[C_RK + h * DH + lane]) + q1 * bf2f(rp[C_RK + h * DH + lane + 64]), lane) * exp2f((float)(t - j) * lg);
        o0 += dot * bf2f(rp[C_RV + h * DH + lane]); o1 += dot * bf2f(rp[C_RV + h * DH + lane + 64]); }
    const float mean = wave_sum(o0 + o1, lane) * (1.0f / DH); const float d0 = o0 - mean, d1 = o1 - mean; const float rstd = 1.0f / sqrtf(wave_sum(d0 * d0 + d1 * d1, lane) * (1.0f / DH) + EPS);
    const float r0 = bf2f(PROJ[(size_t)m * LD + C_RG + h * DH + lane]), r1 = bf2f(PROJ[(size_t)m * LD + C_RG + h * DH + lane + 64]);
    float* e = CHK + ((size_t)F.bx * NH + h) * DH;
    e[lane] = r0 / (1.0f + expf(-r0)) * (d0 * rstd * gnw[h * DH + lane] + gnb[h * DH + lane]); e[lane + 64] = r1 / (1.0f + expf(-r1)) * (d1 * rstd * gnw[h * DH + lane + 64] + gnb[h * DH + lane + 64]);
}
__device__ __forceinline__ void chk_compare(const Frame& F, const bf16* PROJ, const unsigned short* SC, const int* pos, const float* btab, const float* CHK, unsigned* cnt) {
    if (F.bx >= CHK_NS) return;
    const int m = chk_token(F.bx), b = m >> 13, t = m & (SEQ - 1), h = F.wave, lane = F.lane;
    { const float* e = CHK + ((size_t)F.bx * NH + h) * DH; int bad = 0;
#pragma unroll
      for (int q = 0; q < 2; ++q) { const float ex = e[lane + 64 * q], got = bf2f(PROJ[(size_t)m * LD + C_RG + h * DH + lane + 64 * q]); if (!(fabsf(got - ex) <= 0.04f * fabsf(ex) + 0.03f)) ++bad; }
      bad = wave_sum_i(bad, lane); if (lane == 0 && bad) atomicAdd(cnt, (unsigned)bad); }
    const unsigned short* srow = SC + sc_off(b, t >> 7) + (size_t)(t & 127) * (128 * ((t >> 7) + 1));
    const bf16* qp = PROJ + (size_t)m * LD + C_AQ + h * DH; const float q0 = bf2f(qp[lane]), q1 = bf2f(qp[lane + 64]); const int qpos = pos[m]; const float* tab = btab + h * BIAS_PITCH;
    float mrun = -1.0e30f, lrun = 0.f, a0 = 0.f, a1 = 0.f;
#pragma unroll 1
    for (int g = 0; g < 4; ++g) { if (2048 * g > t) break;
        unsigned K[32]; int cn[32];
#pragma unroll
        for (int i = 0; i < 32; ++i) { const int s_ = 64 * (32 * g + i) + lane; unsigned u = srow[s_ <= t ? s_ : t]; u ^= (u >> 15) ? 0xffffu : 0x8000u; K[i] = s_ <= t ? ((u << 13) | (unsigned)(8191 - s_)) : 0u; cn[i] = 0; }
#pragma unroll 1
        for (int sp = 0; sp <= t; ++sp) { unsigned u = srow[sp]; u ^= (u >> 15) ? 0xffffu : 0x8000u; const unsigned Ks = (u << 13) | (unsigned)(8191 - sp);
#pragma unroll
            for (int i = 0; i < 32; ++i) cn[i] += (int)((K[i] - Ks) >> 31); }
#pragma unroll
        for (int i = 0; i < 32; ++i) { u64 msk = __ballot(K[i] != 0u && cn[i] < 256);
            while (msk) { const int bit = __builtin_ctzll(msk); msk &= msk - 1; const int s_ = 64 * (32 * g + i) + bit; const bf16* rp = PROJ + (size_t)(b * SEQ + s_) * LD;
                int dd = qpos - pos[b * SEQ + s_]; dd = dd < 0 ? 0 : (dd > 128 ? 128 : dd);
                const float lgt = wave_sum(q0 * bf2f(rp[C_AK + h * DH + lane]) + q1 * bf2f(rp[C_AK + h * DH + lane + 64]), lane) + tab[dd];
                const float mn = fmaxf(mrun, lgt), sc_ = exp2f(mrun - mn), p = exp2f(lgt - mn); mrun = mn;
                lrun = lrun * sc_ + p; a0 = a0 * sc_ + p * bf2f(rp[C_AV + h * DH + lane]); a1 = a1 * sc_ + p * bf2f(rp[C_AV + h * DH + lane + 64]); } } }
    { int bad = 0; const float e0 = a0 / lrun, e1 = a1 / lrun; const float g0 = bf2f(PROJ[(size_t)m * LD + C_CC + h * DH + lane]), g1 = bf2f(PROJ[(size_t)m * LD + C_CC + h * DH + lane + 64]);
      if (!(fabsf(g0 - e0) <= 0.04f * fabsf(e0) + 0.01f)) ++bad; if (!(fabsf(g1 - e1) <= 0.04f * fabsf(e1) + 0.01f)) ++bad;
      bad = wave_sum_i(bad, lane); if (lane == 0 && bad) atomicAdd(cnt + 1, (unsigned)bad); }
}
#endif

constexpr int NPH = 25;
#ifndef MK_PHASES
#define MK_PHASES 0xFFFFFFFFu
#endif
#define PHON(i) ((MK_PHASES >> (i)) & 1u)
#ifndef MK_DUP
#define MK_DUP 0u
#endif
#define REPS(i) ((int)((MK_DUP >> (i)) & 1u) + 1)
__global__ void __launch_bounds__(NTHREADS, 2) mk_fwd(Args a) {
    extern __shared__ __attribute__((aligned(16))) unsigned char lds_raw[];
    Frame F; F.lds = (LAS unsigned char*)lds_raw; F.tid = threadIdx.x; F.lane = F.tid & 63; F.wave = __builtin_amdgcn_readfirstlane(F.tid >> 6); F.G = gridDim.x; F.bx = blockIdx.x; F.ws = a.ws;
    unsigned* ctl0 = (unsigned*)(a.ws + WS_CTL);
    for (int u = F.tid; u < (LDS_BYTES - LDSCTL_OFF) / 4; u += NTHREADS) ((LAS unsigned*)(F.lds + LDSCTL_OFF))[u] = 0u;
    __syncthreads();
    const int wave0 = F.wave;
    const int lo = a.ph_lo, hi = a.ph_hi; const bool multi = (hi - lo) > 1;
    XcdBarrier bar; bar.bar = ctl0 + CW_BAR; bar.x = 0; bar.st = (volatile LAS unsigned*)(F.lds + LDSCTL_OFF + 64);
    if (multi) bar = xcd_barrier_post(ctl0 + CW_BAR, (volatile LAS unsigned*)(F.lds + LDSCTL_OFF + 64));
#define IN(k) (lo <= (k) && (k) < hi)
#define SEAM(k) do { if (IN(k) && IN((k) + 1)) xcd_barrier(bar); } while (0)
#define PB() do { int l_; asm volatile("v_mbcnt_lo_u32_b32 %0, -1, 0\n\tv_mbcnt_hi_u32_b32 %0, -1, %0" : "=v"(l_)); const int t_ = (wave0 << 6) + l_; F.tid = t_; F.lane = l_; F.wave = wave0; } while (0)
    const float* x_in = (const float*)a.in[0];

    const bool one_launch = lo == 0 && hi >= 2;
    if (PHON(0) && IN(0)) _Pragma("unroll 1") for (int rp_ = 0; rp_ < REPS(0); ++rp_) { PB(); ph_prologue(F, a); }
    if (one_launch && PHON(1)) { PB(); unsigned char* ws0 = F.ws; ph_rmsnorm<false>(F, x_in, (const float*)a.in[3], (bf16*)(ws0 + WS_XN), nullptr, nullptr, nullptr, ws0 + WS_XN8); }
    SEAM(0);
#pragma unroll 1
    for (int l = 0; l < 2; ++l) {
        const int pb = l == 0 ? 1 : 12;
        unsigned long long wsi_ = (unsigned long long)a.ws, outi_ = (unsigned long long)a.out; asm volatile("" : "+s"(wsi_), "+s"(outi_));
        unsigned char* ws = (unsigned char*)(GAS unsigned char*)wsi_; float* out = (float*)(GAS float*)outi_;
        bf16* PROJ = (bf16*)(ws + WS_PROJ); bf16* XN = (bf16*)(ws + WS_XN); float* KVS = (float*)(ws + WS_KVS); unsigned short* SC = (unsigned short*)(ws + WS_SC); u64* MASK = (u64*)(ws + WS_MASK);
        const CvmCtx cvm{(const float*)a.in[17], (const float*)a.in[18], (const float*)a.in[19], ws + WS_M13, ws + WS_M2};
        unsigned char* misc = ws + WS_MISC; const int* pos = (const int*)a.in[1]; unsigned* ctl = (unsigned*)(ws + WS_CTL);
        const float* xcur = l == 0 ? x_in : out;
        const bool fuse = (F.G & 7) == 0; const pg8::PG8_LASF* rstab = (const pg8::PG8_LASF*)(F.lds + pg8::STAGE_BYTES); const int rbase = (F.bx & 7) * 2048;
        if (!(fuse && l == 1) && !(one_launch && l == 0)) {
        if (PHON(1) && IN(pb + 0)) _Pragma("unroll 1") for (int rp_ = 0; rp_ < REPS(1); ++rp_) { PB(); ph_rmsnorm<false>(F, xcur, (const float*)a.in[3] + l * DM, XN, nullptr, nullptr, nullptr, ws + WS_XN8); }
        SEAM(pb + 0); }
        if (PHON(2) && IN(pb + 1)) _Pragma("unroll 1") for (int rp_ = 0; rp_ < REPS(2); ++rp_) { PB(); const bool fz = fuse && l == 1; if (fz) rstd_table(F, (const float*)(ws + WS_SSQ)); { pg8::Gemm g{(const bf16*)(ws + WS_XN8), (const bf16*)(ws + WS_WIN8 + (size_t)l * 6144 * DM), T, 6144, DM / 2, DM / 2, DM / 2}; pg8::StaticOrder S; S.init(T, 6144, F.G, F.bx);
            pg8::EpiProj E{PROJ, 24, 1.0f / pg8::F8_WSCALE, fz ? rstab : nullptr, rbase}; pg8::gemm_phase<pg8::EpiProj, pg8::StaticOrder, true, true, true>(F.lds, g, S, E, F.tid); }
            PB(); { pg8::Gemm g{(const bf16*)(ws + WS_XN8), (const bf16*)(ws + WS_WIN + (size_t)l * LD * DM * 2), T, 3072, DM / 2, DM / 2, DM / 2}; pg8::StaticOrder S; S.init(T, 3072, F.G, F.bx);
            pg8::EpiProjQK E{PROJ + C_AQ, 1.0f / pg8::F8_WSCALE, (const float*)a.in[11] + l * DH, (const float*)a.in[12] + l * DH, fz ? rstab : nullptr, rbase, (pg8::PG8_LASF*)(F.lds + pg8::STAGE_BYTES + 8192)};
            pg8::gemm_phase<pg8::EpiProjQK, pg8::StaticOrder, true, true, true>(F.lds, g, S, E, F.tid); }
            PB(); { pg8::Gemm g{XN, (const bf16*)(ws + WS_WIN) + (size_t)l * LD * DM + (size_t)C_RQ * DM, T, C_AQ - C_RQ, DM, DM, DM}; pg8::StaticOrder S; S.init(T, C_AQ - C_RQ, F.G, F.bx);
            pg8::EpiProjRot E{PROJ + C_RQ, pos, fz ? rstab : nullptr, rbase}; pg8::gemm_phase<pg8::EpiProjRot, pg8::StaticOrder, true, true>(F.lds, g, S, E, F.tid); }
            PB(); { pg8::Gemm g{XN, (const bf16*)(ws + WS_WIN) + (size_t)l * LD * DM + (size_t)C_IQ * DM, T, LD - C_IQ, DM, DM, DM}; pg8::StaticOrder S; S.init(T, LD - C_IQ, F.G, F.bx);
            pg8::EpiProj E{PROJ + C_IQ, 0, 1.0f, fz ? rstab : nullptr, rbase}; pg8::gemm_phase<pg8::EpiProj, pg8::StaticOrder, true, true>(F.lds, g, S, E, F.tid); } }
        SEAM(pb + 1);
        if (IN(pb + 2)) { const int sw_ = (F.bx >> 3) & 1; _Pragma("unroll 1") for (int part_ = 0; part_ < 2; ++part_) { __syncthreads(); PB();
            if ((part_ ^ sw_) == 0) { if (PHON(3)) ph_prep(F, PROJ, pos, (const float*)a.in[10] + l * 3 * MIXW, (const float*)a.in[11] + l * DH, (const float*)a.in[12] + l * DH); }
            else { if (PHON(4)) _Pragma("unroll 1") for (int rp_ = 0; rp_ < REPS(4); ++rp_) ph_scores(F, PROJ, SC); } } }
        SEAM(pb + 2);
        if (IN(pb + 3)) { const int sw_ = (F.bx >> 3) & 1; _Pragma("unroll 1") for (int part_ = 0; part_ < 2; ++part_) { __syncthreads(); PB();
            if ((part_ ^ sw_) == 0) { if (PHON(5)) _Pragma("unroll 1") for (int rp_ = 0; rp_ < REPS(5); ++rp_) for (int u = F.bx; u < 1024; u += F.G) kv_unit(F, PROJ, KVS, u, cvm, l * CVM_LAYER); }
            else { if (PHON(6)) _Pragma("unroll 1") for (int rp_ = 0; rp_ < REPS(6); ++rp_) ph_select(F, SC, MASK, cvm, l * CVM_LAYER); } } }
        SEAM(pb + 3);
        if (PHON(7) && IN(pb + 4)) _Pragma("unroll 1") for (int rp_ = 0; rp_ < REPS(7); ++rp_) { PB(); ph_scan(F, KVS);
#if MK_CHECK
            PB(); chk_ret_expected(F, PROJ, (const float*)a.in[8] + l * MIXW, (const float*)a.in[9] + l * MIXW, (float*)(misc + MS_CHK));
#endif
        }
        SEAM(pb + 4);
        if (IN(pb + 5)) { const int sw_ = (F.bx >> 3) & 1;
            AttnCtx C{PROJ, MASK, pos, (const int*)(misc + MS_POSMIN), (const int*)(misc + MS_POSMAX), (const float*)(misc + MS_BIAS), ((const float*)(misc + MS_M2))[l]};
            _Pragma("unroll 1") for (int part_ = 0; part_ < 2; ++part_) { __syncthreads(); PB();
            if ((part_ ^ sw_) == 0) { if (PHON(8)) _Pragma("unroll 1") for (int rp_ = 0; rp_ < REPS(8); ++rp_) for (int pu = F.bx; pu < 256; pu += F.G) { const int pid = (pu & 7) * 32 + (pu >> 3), bh = pid >> 4, pr = pid & 15;
#pragma unroll 1
                for (int hf = 0; hf < 2; ++hf) attn_unit(F, C, bh >> 3, bh & 7, hf ? pr : 31 - pr, rp_ + 1 < REPS(8)); } }
            else { if (PHON(9)) for (int u = F.bx; u < 1024; u += F.G) ret_unit(F, PROJ, KVS, (const float*)a.in[8] + l * MIXW, (const float*)a.in[9] + l * MIXW, u, cvm, l * CVM_LAYER); } }
        }
        SEAM(pb + 5);
        if (PHON(10) && IN(pb + 6)) _Pragma("unroll 1") for (int rp_ = 0; rp_ < REPS(10); ++rp_) {
#if MK_CHECK
            PB(); chk_compare(F, PROJ, SC, pos, (const float*)(misc + MS_BIAS), (const float*)(misc + MS_CHK), ctl + CW_CHK);
#endif
            PB(); pg8::StaticOrder S; S.init(T, DM, F.G, F.bx);
            pg8::Gemm g{PROJ + C_RG, (const bf16*)(ws + WS_WBR) + (size_t)l * DM * 3 * MIXW, T, DM, 3 * MIXW, LD, 3 * MIXW}; pg8::EpiGate3 E{PROJ + C_G, XN};
            pg8::gemm_phase<pg8::EpiGate3, pg8::StaticOrder, true, true>(F.lds, g, S, E, F.tid); }
        SEAM(pb + 6);
        if (PHON(11) && IN(pb + 7)) { PB(); pg8::Gemm g{XN, (const bf16*)(ws + WS_WO) + (size_t)l * DM * DM, T, DM, DM, DM, DM}; pg8::StaticOrder S; S.init(T, DM, F.G, F.bx);
            const bool fz = fuse && l == 0;
            if (fz) gains_to_lds(F, (const float*)a.in[4]);
            pg8::EpiResid E{xcur, out, (const pg8::PG8_LASF*)(F.lds + pg8::STAGE_BYTES), fz ? (bf16*)(ws + WS_XB2) : nullptr, nullptr, (float*)(ws + WS_SSQ)}; pg8::gemm_phase<pg8::EpiResid, pg8::StaticOrder, true, true>(F.lds, g, S, E, F.tid); }
        SEAM(pb + 7);
        if (l == 0) {
            if (!fuse) { if (PHON(1) && IN(pb + 8)) { PB(); ph_rmsnorm<false>(F, out, (const float*)a.in[4], XN, nullptr, nullptr, nullptr); }
            SEAM(pb + 8); }
            if (PHON(12) && IN(pb + 9)) _Pragma("unroll 1") for (int rp_ = 0; rp_ < REPS(12); ++rp_) { PB(); if (fuse) rstd_table(F, (const float*)(ws + WS_SSQ)); pg8::Gemm g{fuse ? (const bf16*)(ws + WS_XB2) : XN, (const bf16*)(ws + WS_W13), T, 2 * DFF, DM, DM, DM}; pg8::StaticOrder S; S.init(T, 2 * DFF, F.G, F.bx);
                pg8::EpiSwiglu E{(bf16*)(ws + WS_ACT), DFF, 1 << 20, fuse ? rstab : nullptr, rbase}; pg8::gemm_phase<pg8::EpiSwiglu, pg8::StaticOrder, true, true>(F.lds, g, S, E, F.tid); }
            SEAM(pb + 9);
            if (PHON(13) && IN(pb + 10)) { PB(); pg8::Gemm g{(const bf16*)(ws + WS_ACT), (const bf16*)(ws + WS_W2), T, DM, DFF, DFF, DFF}; pg8::StaticOrder S; S.init(T, DM, F.G, F.bx);
                if (fuse) gains_to_lds(F, (const float*)a.in[3] + DM);
                pg8::EpiResid E{out, out, (const pg8::PG8_LASF*)(F.lds + pg8::STAGE_BYTES), fuse ? XN : nullptr, ws + WS_XN8, (float*)(ws + WS_SSQ)};
                pg8::gemm_phase<pg8::EpiResid, pg8::StaticOrder, true, true>(F.lds, g, S, E, F.tid); }
            SEAM(pb + 10);
        } else {
            u32x4* route = (u32x4*)(misc + MS_ROUTE); int* tokslot = (int*)(misc + MS_TOKSLOT); int* tiles = (int*)(misc + MS_TILES);
            if (PHON(14) && IN(pb + 8)) { PB(); ph_rmsnorm<true>(F, out, (const float*)a.in[4] + DM, nullptr, (const float*)a.in[16], route, ctl + CW_CNT, ws + WS_XN8); }
            SEAM(pb + 8);
            if (PHON(15) && IN(pb + 9)) { PB(); ph_assign(F, route, ctl + CW_CNT, ctl + CW_CUR, tiles, tokslot, ws + WS_XN8, ws + WS_HPERM); }
            SEAM(pb + 9);
            if (PHON(16) && IN(pb + 10)) _Pragma("unroll 1") for (int rp_ = 0; rp_ < REPS(16); ++rp_) { PB(); pg8::MoeOrder S; S.init(tiles, 2 * DFFE / 256, F.G, F.bx); pg8::Gemm g{(const bf16*)(ws + WS_HPERM), (const bf16*)(ws + WS_M13), MAXSLOT, 2 * DFFE, DM / 2, DM / 2, DM / 2};
                pg8::EpiSwigluF8 E{ws + WS_MACT, DFFE, 2 * DFFE / 256}; pg8::gemm_phase<pg8::EpiSwigluF8, pg8::MoeOrder, true, true, true>(F.lds, g, S, E, F.tid); }
            SEAM(pb + 10);
            if (PHON(17) && IN(pb + 11)) _Pragma("unroll 1") for (int rp_ = 0; rp_ < REPS(17); ++rp_) { PB(); pg8::MoeOrder S; S.init(tiles, DM / 256, F.G, F.bx, true, DFFE / 2); pg8::Gemm g{(const bf16*)(ws + WS_MACT), (const bf16*)(ws + WS_M2), MAXSLOT, DM, DFFE / 2, DFFE / 2, DFFE / 2};
                pg8::EpiBf16Slot E{(bf16*)(ws + WS_YSLOT), (bf16*)(ws + WS_PART), 1.0f / (pg8::F8_WSCALE * pg8::F8_ASCALE)}; pg8::gemm_phase<pg8::EpiBf16Slot, pg8::MoeOrder, true, true, true>(F.lds, g, S, E, F.tid); }
            SEAM(pb + 11);
            if (PHON(18) && IN(pb + 12)) { PB(); ph_combine(F, out, (const bf16*)(ws + WS_YSLOT), (const bf16*)(ws + WS_PART), route, tokslot, tiles);
#if MK_CHECK
                __syncthreads();
                if (F.bx == 0 && F.tid == 0) { const unsigned br = __hip_atomic_load(ctl + CW_CHK, __ATOMIC_RELAXED, __HIP_MEMORY_SCOPE_AGENT), ba = __hip_atomic_load(ctl + CW_CHK + 1, __ATOMIC_RELAXED, __HIP_MEMORY_SCOPE_AGENT);
                    if ((MK_CHECK & 1) && br > 2u * CHK_NS * NH * DH / 100u) out[0] = __builtin_nanf(""); if ((MK_CHECK & 2) && ba > 2u * CHK_NS * NH * DH / 100u) out[1] = __builtin_nanf(""); }
#endif
            }
        }
    }
#undef IN
#undef SEAM
}

#ifndef MK_ONE_LAUNCH
#define MK_ONE_LAUNCH 1
#endif
extern "C" void kernel_launch(void* const* d_in, const int* in_sizes, int n_in, void* d_out, int out_size, void* d_ws, size_t ws_size, hipStream_t stream) {
    static int grid = 0;
    if (grid == 0) {
        if (n_in != 20 || out_size != T * DM || ws_size < WS_END) { fprintf(stderr, "kernel_launch: unexpected shapes (n_in %d out %d ws %zu need %zu)\n", n_in, out_size, ws_size, (size_t)WS_END); grid = -1; return; }
        int dev = 0, cus = 0, per_cu = 0;
        if (hipGetDevice(&dev) != hipSuccess || hipDeviceGetAttribute(&cus, hipDeviceAttributeMultiprocessorCount, dev) != hipSuccess) { grid = -1; return; }
        if (hipFuncSetAttribute((const void*)mk_fwd, hipFuncAttributeMaxDynamicSharedMemorySize, LDS_BYTES) != hipSuccess) { fprintf(stderr, "kernel_launch: hipFuncSetAttribute failed\n"); grid = -1; return; }
        if (hipOccupancyMaxActiveBlocksPerMultiprocessor(&per_cu, (const void*)mk_fwd, NTHREADS, LDS_BYTES) != hipSuccess || per_cu < 1) fprintf(stderr, "kernel_launch: occupancy query says %d\n", per_cu);
        (void)hipGetLastError();
        grid = cus;
    }
    if (grid < 0) return;
    if (hipMemsetAsync((char*)d_ws + WS_CTL, 0, CTL_ZERO_BYTES, stream) != hipSuccess) return;
    Args a{};
    for (int i = 0; i < 20; ++i) a.in[i] = d_in[i];
    a.out = (float*)d_out; a.ws = (unsigned char*)d_ws;
#if MK_ONE_LAUNCH
    a.ph_lo = 0; a.ph_hi = NPH;
    hipLaunchKernelGGL(mk_fwd, dim3(grid), dim3(NTHREADS), LDS_BYTES, stream, a);
#else
    for (int p = 0; p < NPH; ++p) { a.ph_lo = p; a.ph_hi = p + 1; hipLaunchKernelGGL(mk_fwd, dim3(grid), dim3(NTHREADS), LDS_BYTES, stream, a); }
#endif
}
```

```cpp
#include <hip/hip_runtime.h>
#include <cstdio>
#include <cstdint>

#define GAS __attribute__((address_space(1)))
#define LAS __attribute__((address_space(3)))
namespace pg8 {
#define PG8_LAS __attribute__((address_space(3)))
typedef unsigned short bf16_t;
typedef short bf16x8 __attribute__((ext_vector_type(8)));
typedef float f32x4 __attribute__((ext_vector_type(4)));
typedef unsigned u32x4 __attribute__((ext_vector_type(4)));
constexpr int BM = 256, BK = 64, HALF = 128, HTB = HALF * BK * 2  , STAGE_BYTES = 8 * HTB, NXCD = 8, WGM = 8;

__host__ __device__ __forceinline__ int lds_byte(int r, int c) { const int st = (r >> 4) * 2 + (c >> 5), rr = r & 15, cc = c & 31, ob = rr * 64 + cc * 2; return st * 1024 + (ob ^ (((ob >> 9) & 1) << 5)); }
__host__ __device__ __forceinline__ void stage_rc(int b, int& R, int& C) { const int st = b / 1024, sb = b % 1024, swz = sb ^ (((sb >> 9) & 1) << 5); R = (st >> 1) * 16 + swz / 64; C = (st & 1) * 32 + (swz % 64) / 2; }
__host__ __device__ __forceinline__ int perm32(int rho) { const int n = rho >> 4, i = rho & 15; return 8 * (i >> 2) + 4 * n + (i & 3); }

struct Unit { int pm, pn, koff, nt, z; };
struct Gemm { const bf16_t* A; const bf16_t* Bt; int M, N, K, lda, ldb; };

struct StaticOrder {
    int nM, nN, nwg, G, c;
    __host__ __device__ void init(int M, int N, int G_, int c_) { nM = M / BM; nN = N / BM; nwg = nM * nN; G = G_; c = c_; }
    __host__ __device__ bool next(int i, Unit& u) const {
        const long L = (long)i * G + c; if (L >= nwg) return false;
        int wgid = (int)L; { const int q = nwg / NXCD, r = nwg % NXCD, xcd = wgid % NXCD, off = wgid / NXCD; wgid = (xcd < r ? xcd * (q + 1) : r * (q + 1) + (xcd - r) * q) + off; }
        const int nig = WGM * nN, gid = wgid / nig, fm = gid * WGM, gsz = (nM - fm) < WGM ? (nM - fm) : WGM;
        u.pm = fm + ((wgid % nig) % gsz); u.pn = (wgid % nig) / gsz; u.koff = 0; u.nt = 0; u.z = 0; return true;
    }
    __device__ __forceinline__ void a_ready(const Unit&) const {}
    __device__ __forceinline__ void done(const Unit&) const {}
};

typedef float f32x2_t __attribute__((ext_vector_type(2)));
typedef __bf16 bf16x2_t __attribute__((ext_vector_type(2)));
__device__ __forceinline__ unsigned cvt_pk_bf16(float lo, float hi) { f32x2_t v = {lo, hi}; bf16x2_t b = __builtin_convertvector(v, bf16x2_t); return __builtin_bit_cast(unsigned, b); }
__device__ __forceinline__ unsigned cvt_pk4_fp8(float a, float b, float c, float d) { int r = __builtin_amdgcn_cvt_pk_fp8_f32(a, b, 0, false); r = __builtin_amdgcn_cvt_pk_fp8_f32(c, d, r, true); return (unsigned)r; }
constexpr float F8_WSCALE = 64.f, F8_ASCALE = 4.f;

typedef PG8_LAS float PG8_LASF;
typedef int i32x4_t __attribute__((ext_vector_type(4)));
typedef int i32x8_t __attribute__((ext_vector_type(8)));
__device__ __forceinline__ i32x8_t cat8(bf16x8 a, bf16x8 b) { return __builtin_shufflevector(__builtin_bit_cast(i32x4_t, a), __builtin_bit_cast(i32x4_t, b), 0, 1, 2, 3, 4, 5, 6, 7); }
template <class Epi, class Sched, bool ALIGN_EPI = false, bool SP2 = false, bool FP8 = false>
__device__ __forceinline__ void gemm_phase(PG8_LAS unsigned char* lds, const Gemm g, const Sched& S, const Epi& E, const int tid_in) {
    const int tid = tid_in, wid = __builtin_amdgcn_readfirstlane(tid >> 6), lane = tid & 63, wr = wid >> 2, wc = wid & 3, fr = lane & 15, fq = lane >> 4;
    const int ntf = g.K / BK; int nt;
    unsigned voffA[2], voffB[2];
#pragma unroll
    for (int i = 0; i < 2; ++i) { int R, C; stage_rc(tid * 16 + i * 8192, R, C); const int Rb = Epi::PERM ? ((R & ~31) + perm32(R & 31)) : R;
        voffA[i] = (unsigned)(R * g.lda + C) * 2u; voffB[i] = (unsigned)(Rb * g.ldb + C) * 2u; }
    const size_t kstep = (size_t)(BK * 2);
    const size_t hstepB = (size_t)HALF * g.ldb * 2, hstepA = (size_t)HALF * g.lda * 2;
    const size_t tstepA = 2 * hstepA, tstepB = 2 * hstepB;
    const unsigned ldsw = (unsigned)wid * 1024u;
    const int aoff = lds_byte(wr * 64 + fr, fq * 8), boff = lds_byte(wc * 32 + fr, fq * 8);
#define PG8_SA(b, h) (((b) * 2 + (h)) * HTB)
#define PG8_SB(b, h) ((4 + (b) * 2 + (h)) * HTB)
#define PG8_STAGE(bufoff, gbase, voff) do { _Pragma("unroll") for (int _i = 0; _i < 2; ++_i) \
        __builtin_amdgcn_global_load_lds((const unsigned*)((const char*)(gbase) + (voff)[_i]), (PG8_LAS unsigned*)(lds + (bufoff) + ldsw + _i * 8192), 16, 0, 0); } while (0)
#define PG8_LDA(dst, b, h) do { if constexpr (FP8) { _Pragma("unroll") for (int m = 0; m < 4; ++m) dst##8[m] = cat8(*(const PG8_LAS bf16x8*)(lds + PG8_SA(b, h) + aoff + m * 2048), *(const PG8_LAS bf16x8*)(lds + PG8_SA(b, h) + aoff + m * 2048 + 1024)); } \
        else { _Pragma("unroll") for (int m = 0; m < 4; ++m) _Pragma("unroll") for (int k = 0; k < 2; ++k) dst[m][k] = *(const PG8_LAS bf16x8*)(lds + PG8_SA(b, h) + aoff + m * 2048 + k * 1024); } } while (0)
#define PG8_LDB(dst, b, h) do { if constexpr (FP8) { _Pragma("unroll") for (int n = 0; n < 2; ++n) dst##8[n] = cat8(*(const PG8_LAS bf16x8*)(lds + PG8_SB(b, h) + boff + n * 2048), *(const PG8_LAS bf16x8*)(lds + PG8_SB(b, h) + boff + n * 2048 + 1024)); } \
        else { _Pragma("unroll") for (int n = 0; n < 2; ++n) _Pragma("unroll") for (int k = 0; k < 2; ++k) dst[n][k] = *(const PG8_LAS bf16x8*)(lds + PG8_SB(b, h) + boff + n * 2048 + k * 1024); } } while (0)
#define PG8_MMA(ai, bj, At, Bt) do { __builtin_amdgcn_s_setprio(1); if constexpr (FP8) { _Pragma("unroll") for (int m = 0; m < 4; ++m) _Pragma("unroll") for (int n = 0; n < 2; ++n) \
        asm volatile("v_mfma_scale_f32_16x16x128_f8f6f4 %0, %1, %2, %0, %3, %3 op_sel_hi:[0,0,0]" : "+v"(acc[ai][bj][m][n]) : "v"(Bt##8[n]), "v"(At##8[m]), "v"(f8scale)); } \
        else { _Pragma("unroll") for (int m = 0; m < 4; ++m) _Pragma("unroll") for (int n = 0; n < 2; ++n) _Pragma("unroll") for (int k = 0; k < 2; ++k) \
        acc[ai][bj][m][n] = __builtin_amdgcn_mfma_f32_16x16x32_bf16(Bt[n][k], At[m][k], acc[ai][bj][m][n], 0, 0, 0); } __builtin_amdgcn_s_setprio(0); } while (0)
#define PG8_WAIT_V(n) asm volatile("s_waitcnt vmcnt(" #n ")" ::: "memory")
#define PG8_WAIT_L(n) asm volatile("s_waitcnt lgkmcnt(" #n ")" ::: "memory")
#define PG8_BAR __builtin_amdgcn_s_barrier()
#define PG8_SCHED __builtin_amdgcn_sched_barrier(0)
    Unit cur, nxt; int ui = 0;
    if (!S.next(0, cur)) return;
    const int f8scale = 0x7F7F7F7F;
    f32x4 acc[2][2][4][2];
#pragma unroll
    for (int a = 0; a < 2; ++a)
#pragma unroll
        for (int b = 0; b < 2; ++b)
#pragma unroll
            for (int m = 0; m < 4; ++m)
#pragma unroll
                for (int n = 0; n < 2; ++n) acc[a][b][m][n] = (f32x4){0.f, 0.f, 0.f, 0.f};
    bf16x8 At[4][2], B0[2][2], B1[2][2]; i32x8_t At8[4], B08[2], B18[2];
    const char* cA = (const char*)g.A + (size_t)cur.pm * tstepA + (size_t)cur.koff * 2; const char* cB = (const char*)g.Bt + (size_t)cur.pn * tstepB + (size_t)cur.koff * 2; nt = cur.nt ? cur.nt : ntf;
    S.a_ready(cur);
    if constexpr (SP2) {
        PG8_STAGE(PG8_SB(0, 0), cB, voffB); PG8_STAGE(PG8_SB(0, 1), cB + hstepB, voffB); PG8_STAGE(PG8_SA(0, 0), cA, voffA); PG8_STAGE(PG8_SA(0, 1), cA + hstepA, voffA);
        if (wr == 1) PG8_BAR;
        PG8_WAIT_V(2); PG8_BAR;
        PG8_STAGE(PG8_SB(1, 0), cB + kstep, voffB); PG8_STAGE(PG8_SA(1, 0), cA + kstep, voffA); PG8_STAGE(PG8_SB(1, 1), cB + hstepB + kstep, voffB);
        PG8_WAIT_V(6); PG8_BAR;
    } else {
        PG8_STAGE(PG8_SB(0, 0), cB, voffB); PG8_STAGE(PG8_SA(0, 0), cA, voffA); PG8_STAGE(PG8_SB(0, 1), cB + hstepB, voffB); PG8_STAGE(PG8_SA(0, 1), cA + hstepA, voffA);
        if (wr == 1) PG8_BAR;
        PG8_WAIT_V(4); PG8_BAR;
        PG8_STAGE(PG8_SB(1, 0), cB + kstep, voffB); PG8_STAGE(PG8_SA(1, 0), cA + kstep, voffA); PG8_STAGE(PG8_SB(1, 1), cB + hstepB + kstep, voffB);
        PG8_WAIT_V(6); PG8_BAR;
    }
    for (;;) {
        const bool has_next = S.next(ui + 1, nxt);
        const char* nA = has_next ? (const char*)g.A + (size_t)nxt.pm * tstepA + (size_t)nxt.koff * 2 : cA; const char* nB = has_next ? (const char*)g.Bt + (size_t)nxt.pn * tstepB + (size_t)nxt.koff * 2 : cB;
        for (int t = 0; t < nt; t += 2) {
            if constexpr (Epi::MIDK > 0) { if (t > 0 && (t % Epi::MIDK) == 0) E.mid(acc, cur, wr, wc, fr, fq, t / Epi::MIDK); }
            const bool last = (t == nt - 2);
            const char* a1 = cA + (size_t)(t + 1) * kstep;
            const char* a2 = last ? nA : cA + (size_t)(t + 2) * kstep; const char* b2 = last ? nB : cB + (size_t)(t + 2) * kstep;
            const char* a3 = a2 + kstep; const char* b3 = b2 + kstep;
            if (last && has_next) S.a_ready(nxt);
            if constexpr (SP2) {
            PG8_LDB(B0, 0, 0); PG8_LDB(B1, 0, 1); PG8_SCHED; PG8_LDA(At, 0, 0); PG8_STAGE(PG8_SA(1, 1), a1 + hstepA, voffA);
            PG8_WAIT_V(8); PG8_WAIT_L(0); PG8_BAR; PG8_MMA(0, 0, At, B0); PG8_MMA(0, 1, At, B1); PG8_BAR; PG8_SCHED;
            PG8_LDA(At, 0, 1); PG8_STAGE(PG8_SB(0, 0), b2, voffB); PG8_STAGE(PG8_SB(0, 1), b2 + hstepB, voffB); PG8_STAGE(PG8_SA(0, 0), a2, voffA);
            PG8_WAIT_V(8); PG8_WAIT_L(0); PG8_BAR; PG8_MMA(1, 0, At, B0); PG8_MMA(1, 1, At, B1); PG8_BAR; PG8_SCHED;
            PG8_LDB(B0, 1, 0); PG8_LDB(B1, 1, 1); PG8_SCHED; PG8_LDA(At, 1, 0); PG8_STAGE(PG8_SA(0, 1), a2 + hstepA, voffA);
            PG8_WAIT_V(8); PG8_WAIT_L(0); PG8_BAR; PG8_MMA(0, 0, At, B0); PG8_MMA(0, 1, At, B1); PG8_BAR; PG8_SCHED;
            PG8_LDA(At, 1, 1); PG8_STAGE(PG8_SB(1, 0), b3, voffB); PG8_STAGE(PG8_SB(1, 1), b3 + hstepB, voffB); PG8_STAGE(PG8_SA(1, 0), a3, voffA);
            PG8_WAIT_V(8); PG8_WAIT_L(0); PG8_BAR; PG8_MMA(1, 0, At, B0); PG8_MMA(1, 1, At, B1); PG8_BAR; PG8_SCHED;
            } else {
            PG8_LDB(B0, 0, 0); PG8_SCHED; PG8_LDA(At, 0, 0); PG8_STAGE(PG8_SA(1, 1), a1 + hstepA, voffA);
            PG8_WAIT_L(8); PG8_BAR; PG8_WAIT_L(0); PG8_MMA(0, 0, At, B0); PG8_BAR; PG8_SCHED;
            PG8_LDB(B1, 0, 1); PG8_STAGE(PG8_SB(0, 0), b2, voffB);
            PG8_BAR; PG8_WAIT_L(0); PG8_MMA(0, 1, At, B1); PG8_BAR;
            PG8_LDA(At, 0, 1); PG8_STAGE(PG8_SA(0, 0), a2, voffA);
            PG8_BAR; PG8_WAIT_L(0); PG8_MMA(1, 0, At, B0); PG8_BAR; PG8_SCHED;
            PG8_STAGE(PG8_SB(0, 1), b2 + hstepB, voffB);
            PG8_WAIT_V(6); PG8_BAR; PG8_MMA(1, 1, At, B1); PG8_BAR;
            PG8_LDB(B0, 1, 0); PG8_SCHED; PG8_LDA(At, 1, 0); PG8_STAGE(PG8_SA(0, 1), a2 + hstepA, voffA);
            PG8_WAIT_L(8); PG8_BAR; PG8_WAIT_L(0); PG8_MMA(0, 0, At, B0); PG8_BAR; PG8_SCHED;
            PG8_LDB(B1, 1, 1); PG8_STAGE(PG8_SB(1, 0), b3, voffB);
            PG8_BAR; PG8_WAIT_L(0); PG8_MMA(0, 1, At, B1); PG8_BAR;
            PG8_LDA(At, 1, 1); PG8_STAGE(PG8_SA(1, 0), a3, voffA);
            PG8_BAR; PG8_WAIT_L(0); PG8_MMA(1, 0, At, B0); PG8_BAR; PG8_SCHED;
            PG8_STAGE(PG8_SB(1, 1), b3 + hstepB, voffB);
            PG8_WAIT_V(6); PG8_BAR; PG8_MMA(1, 1, At, B1); PG8_BAR;
            }
        }
        if constexpr (FP8) { asm volatile("s_nop 15\n\ts_nop 15"); PG8_SCHED; }
        if constexpr (ALIGN_EPI) { if (wr == 0) PG8_BAR; }
        if constexpr (!Epi::AFTER_DRAIN) { E(acc, cur, wr, wc, fr, fq); S.done(cur); }
        if (!has_next) break;
#pragma unroll
        for (int a = 0; a < 2; ++a)
#pragma unroll
            for (int b = 0; b < 2; ++b)
#pragma unroll
                for (int m = 0; m < 4; ++m)
#pragma unroll
                    for (int n = 0; n < 2; ++n) acc[a][b][m][n] = (f32x4){0.f, 0.f, 0.f, 0.f};
        cur = nxt; cA = nA; cB = nB; ++ui; nt = cur.nt ? cur.nt : ntf;
        if constexpr (ALIGN_EPI) { if (wr == 1) PG8_BAR; }
    }
    PG8_WAIT_V(0);
    if constexpr (!ALIGN_EPI) { if (wr == 0) PG8_BAR; }
    PG8_BAR;
    if constexpr (Epi::AFTER_DRAIN) { E.fused(acc, cur, wr, wc, fr, fq, lds, wid, lane); S.done(cur); }
#undef PG8_SA
#undef PG8_SB
#undef PG8_STAGE
#undef PG8_LDA
#undef PG8_LDB
#undef PG8_MMA
#undef PG8_WAIT_V
#undef PG8_WAIT_L
#undef PG8_BAR
#undef PG8_SCHED
}
}
#define XB_TMO      128
#define XB_XCNT(j)  (256  + 64 * (j))
#define XB_XSUB(j)  (1280 + 64 * (j))
#define XB_XGEN(j)  (2304 + 64 * (j))
#define XB_TOP      3328
#define XB_TOPGEN   3392
#define XCD_BAR_WORDS 3456
#define XB_SPIN_CAP (1u << 18)

__device__ __forceinline__ unsigned xb_ld(unsigned* p)              { return __hip_atomic_load(p, __ATOMIC_RELAXED, __HIP_MEMORY_SCOPE_AGENT); }
__device__ __forceinline__ unsigned xb_add(unsigned* p, unsigned v) { return __hip_atomic_fetch_add(p, v, __ATOMIC_RELAXED, __HIP_MEMORY_SCOPE_AGENT); }
__device__ __forceinline__ unsigned xb_xcc_id() { return (unsigned)__builtin_amdgcn_s_getreg((3 << 11) | 20) & 0xFu; }
#define XB_SPIN(cond, bar) do { unsigned _sp = 0; while (cond) { __builtin_amdgcn_s_sleep(1); \
    if ((++_sp & 255u) == 0u) { if (xb_ld(&(bar)[XB_TMO])) break; if (_sp > XB_SPIN_CAP) { atomicAdd(&(bar)[XB_TMO], 1u); break; } } } } while (0)

struct XcdBarrier {
    unsigned* bar; unsigned x;
    volatile LAS unsigned* st;
};

__device__ __forceinline__ XcdBarrier xcd_barrier_post(unsigned* bar, volatile LAS unsigned* st) {
    XcdBarrier b; b.bar = bar; b.x = xb_xcc_id(); b.st = st;
    if (threadIdx.x == 0) (void)xb_add(&bar[XB_XCNT(b.x)], 1u);
    return b;
}
__device__ __forceinline__ void xcd_barrier_complete(unsigned* bar, unsigned x, unsigned& nloc, unsigned& nx) {
    const unsigned G = gridDim.x * gridDim.y * gridDim.z;
    unsigned sum, cnt, mine, sp = 0u;
    for (;;) {
        sum = 0u; cnt = 0u; mine = 0u;
#pragma unroll
        for (unsigned j = 0; j < 16; ++j) { const unsigned c = xb_ld(&bar[XB_XCNT(j)]); sum += c; cnt += (c > 0u) ? 1u : 0u; mine = (j == x) ? c : mine; }
        if (sum == G) break;
        __builtin_amdgcn_s_sleep(1);
        if ((++sp & 255u) == 0u) { if (xb_ld(&bar[XB_TMO])) break; if (sp > XB_SPIN_CAP) { atomicAdd(&bar[XB_TMO], 1u); break; } }
    }
    nloc = mine > 0u ? mine : 1u; nx = cnt > 0u ? cnt : 1u;
}

__device__ __forceinline__ void xcd_barrier(const XcdBarrier& b) {
    asm volatile("s_waitcnt vmcnt(0)" ::: "memory");
    __syncthreads();
    if (threadIdx.x == 0) {
        unsigned* bar = b.bar;
        __builtin_amdgcn_s_waitcnt(0);
        unsigned nloc = b.st[0], nx = b.st[1];
        if (nloc == 0u) { xcd_barrier_complete(bar, b.x, nloc, nx); b.st[0] = nloc; b.st[1] = nx; }
        const unsigned old = xb_add(&bar[XB_XSUB(b.x)], 1u);
        const unsigned gen = old / nloc;
        if (old + 1u == (gen + 1u) * nloc) {
            __builtin_amdgcn_fence(__ATOMIC_RELEASE, "agent");
            asm volatile("s_waitcnt vmcnt(0)" ::: "memory");
            const unsigned og = xb_add(&bar[XB_TOP], 1u);
            const unsigned tg = og / nx;
            if (og + 1u == (tg + 1u) * nx) xb_add(&bar[XB_TOPGEN], 1u);
            else XB_SPIN(xb_ld(&bar[XB_TOPGEN]) == tg, bar);
            __builtin_amdgcn_fence(__ATOMIC_ACQUIRE, "agent");
            xb_add(&bar[XB_XGEN(b.x)], 1u);
            asm volatile("s_waitcnt vmcnt(0)" ::: "memory");
        } else {
            XB_SPIN(xb_ld(&bar[XB_XGEN(b.x)]) == gen, bar);
            __builtin_amdgcn_fence(__ATOMIC_ACQUIRE, "agent");
            asm volatile("s_waitcnt vmcnt(0)" ::: "memory");
        }
    }
    __syncthreads();
}

typedef unsigned short bf16;
typedef short bf16x8 __attribute__((ext_vector_type(8)));
typedef short s16x4 __attribute__((ext_vector_type(4)));
typedef float f32x4 __attribute__((ext_vector_type(4)));
typedef float f32x16 __attribute__((ext_vector_type(16)));
typedef unsigned u32x4 __attribute__((ext_vector_type(4)));
typedef unsigned u32x2 __attribute__((ext_vector_type(2)));
typedef unsigned long long u64;

constexpr int NB = 2, SEQ = 8192, T = NB * SEQ, DM = 2048, MIXW = 1024, NH = 8, DH = 128;
constexpr int LD = 17152;
constexpr int C_G = 0, C_RQ = 6144, C_RK = 7168, C_RV = 8192, C_RG = 9216, C_CB = 10240, C_CC = 11264, C_CU = 12288, C_AQ = 13312, C_AK = 14336, C_AV = 15360,
              C_IQ = 16384, C_IK = 16896, C_IW = 16960;
constexpr int IN_COLS = 16968, SRC_GATES = 10824;
constexpr int DFF = 5632, NE = 8, DFFE = 7168, MAXSLOT = 2 * T + NE * 256;
constexpr float EPS = 1e-6f, LOG2E = 1.4426950408889634f;
constexpr int NWAVES = 8, NTHREADS = 512;
constexpr int SCB = 16384 * 2080;

constexpr size_t MiB = 1u << 20;
constexpr size_t WS_CTL = 0, CTL_ZERO_BYTES = 64 * 1024, WS_MISC = 1 * MiB;
constexpr size_t WS_WIN = 4 * MiB, WS_WBR = 138 * MiB, WS_WO = 162 * MiB, WS_W13 = 178 * MiB, WS_W2 = 222 * MiB, WS_M13 = 244 * MiB, WS_M2 = 692 * MiB;
constexpr size_t WS_XN = 916 * MiB, WS_PROJ = 980 * MiB, WS_KVS = 1516 * MiB, WS_SC = 1580 * MiB, WS_MASK = 1840 * MiB;
constexpr size_t WS_XB2 = 1710 * MiB, WS_SSQ = 1774 * MiB;
static_assert(WS_SC + 2ull * SCB * 2 <= WS_XB2 && WS_XB2 + (size_t)T * DM * 2 <= WS_SSQ && WS_SSQ + (size_t)T * 32 * 4 <= 1776 * MiB, "fused norm map");
constexpr size_t WS_XN8 = 1776 * MiB, WS_WIN8 = 1808 * MiB;
static_assert(WS_SC + 2ull * SCB * 2 <= WS_XN8 && WS_XN8 + (size_t)T * DM <= WS_WIN8 && WS_WIN8 + 2ull * 6144 * DM <= WS_MASK, "fp8 w_in map");
constexpr size_t WS_ACT = WS_PROJ;
constexpr size_t WS_HPERM = 980 * MiB, WS_MACT = 1116 * MiB, WS_YSLOT = 1592 * MiB, WS_PART = 1728 * MiB  , WS_END = 1864 * MiB;
static_assert(WS_YSLOT + (size_t)MAXSLOT * DM * 2 <= WS_PART && WS_PART + 256ull * 256 * 256 * 2 <= WS_END, "moe output map");
static_assert(WS_WIN + 2ull * LD * DM * 2 <= WS_WBR && WS_M13 + 8ull * 14336 * 2048 * 2 <= WS_M2 && WS_M2 + 8ull * 2048 * 7168 * 2 <= WS_XN, "weights map");
static_assert(WS_PROJ + (size_t)T * LD * 2 <= WS_KVS && WS_SC + 2ull * SCB * 4 <= WS_MASK && WS_MASK + 2ull * 128 * 8192 * 8 <= WS_END, "act map");
static_assert(WS_HPERM + (size_t)MAXSLOT * DM * 2 <= WS_MACT && WS_MACT + (size_t)MAXSLOT * DFFE * 2 <= WS_YSLOT && WS_YSLOT + (size_t)MAXSLOT * DM * 4 <= WS_END, "moe map");
constexpr size_t MS_POSMIN = 0, MS_POSMAX = 1024, MS_BIAS = 4096, MS_M2 = 12288, MS_TILES = 16384, MS_ROUTE = 65536, MS_TOKSLOT = 393216;
constexpr int BIAS_PITCH = 132;
constexpr int CW_BAR = 4096, CW_CNT = 8192, CW_CUR = 8256;

constexpr int PH_LDS = 143360;
constexpr int LDSCTL_OFF = PH_LDS, LDS_BYTES = 147456;

__device__ __forceinline__ float bf2f(unsigned v) { return __uint_as_float(v << 16); }
__device__ __forceinline__ float bflo(unsigned w) { return __uint_as_float(w << 16); }
__device__ __forceinline__ float bfhi(unsigned w) { return __uint_as_float(w & 0xffff0000u); }
__device__ __forceinline__ unsigned f2bf(float f) { unsigned u = __float_as_uint(f); return (u + 0x7fffu + ((u >> 16) & 1u)) >> 16; }
__device__ __forceinline__ unsigned pk2(float lo, float hi) { return pg8::cvt_pk_bf16(lo, hi); }
__device__ __forceinline__ float fast_exp2(float x) { return __builtin_amdgcn_exp2f(x); }
__device__ __forceinline__ float fast_rcp(float x) { return __builtin_amdgcn_rcpf(x); }
__device__ __forceinline__ float sigmoidf_(float x) { return fast_rcp(1.0f + fast_exp2(-x * LOG2E)); }
__device__ __forceinline__ int xshf_i(int v, int m, int lane) { return __builtin_amdgcn_ds_bpermute((lane ^ m) << 2, v); }
__device__ __forceinline__ float xshf(float v, int m, int lane) { return __int_as_float(__builtin_amdgcn_ds_bpermute((lane ^ m) << 2, __float_as_int(v))); }
__device__ __forceinline__ float lshf(float v, int src, int lane) { (void)lane; return __int_as_float(__builtin_amdgcn_ds_bpermute(src << 2, __float_as_int(v))); }
__device__ __forceinline__ int row16_sum_i(int v) {
    v += __builtin_amdgcn_update_dpp(0, v, 0xB1, 0xF, 0xF, true);
    v += __builtin_amdgcn_update_dpp(0, v, 0x4E, 0xF, 0xF, true);
    v += __builtin_amdgcn_update_dpp(0, v, 0x141, 0xF, 0xF, true);
    v += __builtin_amdgcn_update_dpp(0, v, 0x140, 0xF, 0xF, true);
    return v;
}
__device__ __forceinline__ float row16_sum_f(float v) {
    v += __int_as_float(__builtin_amdgcn_update_dpp(0, __float_as_int(v), 0xB1, 0xF, 0xF, true));
    v += __int_as_float(__builtin_amdgcn_update_dpp(0, __float_as_int(v), 0x4E, 0xF, 0xF, true));
    v += __int_as_float(__builtin_amdgcn_update_dpp(0, __float_as_int(v), 0x141, 0xF, 0xF, true));
    v += __int_as_float(__builtin_amdgcn_update_dpp(0, __float_as_int(v), 0x140, 0xF, 0xF, true));
    return v;
}
__device__ __forceinline__ float wave_sum(float v, int lane) { (void)lane; v = row16_sum_f(v);
    return (__int_as_float(__builtin_amdgcn_readlane(__float_as_int(v), 0)) + __int_as_float(__builtin_amdgcn_readlane(__float_as_int(v), 16))) +
           (__int_as_float(__builtin_amdgcn_readlane(__float_as_int(v), 32)) + __int_as_float(__builtin_amdgcn_readlane(__float_as_int(v), 48))); }
__device__ __forceinline__ float log2gamma(int h) { return log2f(1.0f - exp2f((float)(-5 - h))); }
#define LDS_WAIT() asm volatile("s_waitcnt lgkmcnt(0)" ::: "memory")
#define VM_WAIT() asm volatile("s_waitcnt vmcnt(0)" ::: "memory")

namespace pg8 {
struct EpiProj {
    static constexpr bool PERM = true, AFTER_DRAIN = false; static constexpr int MIDK = 0;
    bf16_t* O; int ngate; float gsc;
    const PG8_LAS float* rs; int rbase;
    __device__ __forceinline__ void operator()(const f32x4 (&acc)[2][2][4][2], const Unit& u, int wr, int wc, int fr, int fq) const {
        const int row0 = u.pm * BM + wr * 64 + fr, col0 = u.pn * BM + wc * 32 + 8 * fq; const bool sg = u.pn < ngate;
#pragma unroll
        for (int ai = 0; ai < 2; ++ai)
#pragma unroll
            for (int m = 0; m < 4; ++m) { bf16_t* rowp = O + (size_t)(row0 + ai * HALF + m * 16) * LD + col0; const float rr = (rs ? rs[(row0 + ai * HALF + m * 16 - rbase) & 2047] : 1.0f) * gsc;
#pragma unroll
                for (int bj = 0; bj < 2; ++bj) { f32x4 v0 = acc[ai][bj][m][0] * rr, v1 = acc[ai][bj][m][1] * rr;
                    if (sg) {
#pragma unroll
                        for (int j = 0; j < 4; ++j) { v0[j] = __builtin_amdgcn_fmed3f(sigmoidf_(v0[j]), 1.0e-6f, 1.0f); v1[j] = __builtin_amdgcn_fmed3f(sigmoidf_(v1[j]), 1.0e-6f, 1.0f); } }
                    u32x4 w; w.x = cvt_pk_bf16(v0[0], v0[1]); w.y = cvt_pk_bf16(v0[2], v0[3]); w.z = cvt_pk_bf16(v1[0], v1[1]); w.w = cvt_pk_bf16(v1[2], v1[3]);
                    *(u32x4*)(rowp + bj * HALF) = w; } }
    }
};
struct EpiProjQK {
    static constexpr bool PERM = true, AFTER_DRAIN = false; static constexpr int MIDK = 0;
    bf16_t* O; float gsc; const float* qn; const float* kn; const PG8_LAS float* rs; int rbase; PG8_LAS float* xl;
    __device__ __forceinline__ void operator()(const f32x4 (&acc)[2][2][4][2], const Unit& u, int wr, int wc, int fr, int fq) const {
        const int row0 = u.pm * BM + wr * 64 + fr, col0 = u.pn * BM + wc * 32 + 8 * fq;
        if (u.pn < 8) {
            const bool isq = u.pn < 4; const float* gp = (isq ? qn : kn) + wc * 32 + 8 * fq; const f32x4 g0 = *(const f32x4*)gp, g1 = *(const f32x4*)(gp + 4);
            const float hs = isq ? 0.08838834764831845f * LOG2E : 1.0f; const int lane = fr + 16 * fq;
#pragma unroll
            for (int ai = 0; ai < 2; ++ai) { float rr[4];
#pragma unroll
                for (int m = 0; m < 4; ++m) { rr[m] = (rs ? rs[(row0 + ai * HALF + m * 16 - rbase) & 2047] : 1.0f) * gsc;
#pragma unroll
                    for (int bj = 0; bj < 2; ++bj) { const f32x4 a = acc[ai][bj][m][0] * rr[m], b = acc[ai][bj][m][1] * rr[m];
                        float sq = ((a[0] * a[0] + a[1] * a[1]) + (a[2] * a[2] + a[3] * a[3])) + ((b[0] * b[0] + b[1] * b[1]) + (b[2] * b[2] + b[3] * b[3]));
                        sq += xshf(sq, 16, lane); sq += xshf(sq, 32, lane);
                        if (fq == 0) xl[(((wr * 64 + m * 16 + fr) * 2 + bj) << 2) + wc] = sq; } }
                asm volatile("s_waitcnt lgkmcnt(0)\n\ts_barrier" ::: "memory");
#pragma unroll
                for (int m = 0; m < 4; ++m) { bf16_t* rowp = O + (size_t)(row0 + ai * HALF + m * 16) * LD + col0;
#pragma unroll
                    for (int bj = 0; bj < 2; ++bj) { const f32x4 pt = *(const PG8_LAS f32x4*)(xl + (((wr * 64 + m * 16 + fr) * 2 + bj) << 2));
                        const float tot = (pt[0] + pt[1]) + (pt[2] + pt[3]); const float sc = rr[m] * hs / sqrtf(tot * (1.0f / 128.0f) + EPS);
                        const f32x4 v0 = acc[ai][bj][m][0] * sc * g0, v1 = acc[ai][bj][m][1] * sc * g1;
                        u32x4 w; w.x = cvt_pk_bf16(v0[0], v0[1]); w.y = cvt_pk_bf16(v0[2], v0[3]); w.z = cvt_pk_bf16(v1[0], v1[1]); w.w = cvt_pk_bf16(v1[2], v1[3]);
                        *(u32x4*)(rowp + bj * HALF) = w; } }
                asm volatile("s_waitcnt lgkmcnt(0)\n\ts_barrier" ::: "memory"); }
        } else {
#pragma unroll
            for (int ai = 0; ai < 2; ++ai)
#pragma unroll
                for (int m = 0; m < 4; ++m) { const int row = row0 + ai * HALF + m * 16; bf16_t* rowp = O + (size_t)row * LD + col0; const float rr = (rs ? rs[(row - rbase) & 2047] : 1.0f) * gsc;
#pragma unroll
                    for (int bj = 0; bj < 2; ++bj) { const f32x4 v0 = acc[ai][bj][m][0] * rr, v1 = acc[ai][bj][m][1] * rr;
                        u32x4 w; w.x = cvt_pk_bf16(v0[0], v0[1]); w.y = cvt_pk_bf16(v0[2], v0[3]); w.z = cvt_pk_bf16(v1[0], v1[1]); w.w = cvt_pk_bf16(v1[2], v1[3]);
                        *(u32x4*)(rowp + bj * HALF) = w; } }
        }
    }
};
struct EpiProjRot {
    static constexpr bool PERM = true, AFTER_DRAIN = false; static constexpr int MIDK = 0;
    bf16_t* O; const int* pos; const PG8_LAS float* rs; int rbase;
    __device__ __forceinline__ void operator()(const f32x4 (&acc)[2][2][4][2], const Unit& u, int wr, int wc, int fr, int fq) const {
        const int row0 = u.pm * BM + wr * 64 + fr, col0 = u.pn * BM + wc * 32 + 8 * fq;
        if (u.pn < 8) {
            float invf[4];
#pragma unroll
            for (int j = 0; j < 4; ++j) invf[j] = __builtin_amdgcn_exp2f(-(float)(4 * (wc * 4 + fq) + j) * 0.20762050593046014f) * 0.15915494309189535f;
            const float ksc = u.pn < 4 ? 1.0f : 0.08838834764831845f;
#pragma unroll
            for (int ai = 0; ai < 2; ++ai)
#pragma unroll
                for (int m = 0; m < 4; ++m) { const int row = row0 + ai * HALF + m * 16; bf16_t* rowp = O + (size_t)row * LD + col0; const float rr = (rs ? rs[(row - rbase) & 2047] : 1.0f) * ksc; const float pf = (float)pos[row];
                    float sn[4], cs[4];
#pragma unroll
                    for (int j = 0; j < 4; ++j) { const float rev = pf * invf[j]; const float frc = rev - __builtin_floorf(rev); sn[j] = __builtin_amdgcn_sinf(frc); cs[j] = __builtin_amdgcn_cosf(frc); }
#pragma unroll
                    for (int bj = 0; bj < 2; ++bj) { const f32x4 x = acc[ai][bj][m][0] * rr, y = acc[ai][bj][m][1] * rr; f32x4 v0, v1;
#pragma unroll
                        for (int j = 0; j < 4; ++j) { v0[j] = x[j] * cs[j] - y[j] * sn[j]; v1[j] = x[j] * sn[j] + y[j] * cs[j]; }
                        u32x4 w; w.x = cvt_pk_bf16(v0[0], v0[1]); w.y = cvt_pk_bf16(v0[2], v0[3]); w.z = cvt_pk_bf16(v1[0], v1[1]); w.w = cvt_pk_bf16(v1[2], v1[3]);
                        *(u32x4*)(rowp + bj * HALF) = w; } }
        } else {
#pragma unroll
            for (int ai = 0; ai < 2; ++ai)
#pragma unroll
                for (int m = 0; m < 4; ++m) { const int row = row0 + ai * HALF + m * 16; bf16_t* rowp = O + (size_t)row * LD + col0; const float rr = rs ? rs[(row - rbase) & 2047] : 1.0f;
#pragma unroll
                    for (int bj = 0; bj < 2; ++bj) { const f32x4 v0 = acc[ai][bj][m][0] * rr, v1 = acc[ai][bj][m][1] * rr;
                        u32x4 w; w.x = cvt_pk_bf16(v0[0], v0[1]); w.y = cvt_pk_bf16(v0[2], v0[3]); w.z = cvt_pk_bf16(v1[0], v1[1]); w.w = cvt_pk_bf16(v1[2], v1[3]);
                        *(u32x4*)(rowp + bj * HALF) = w; } }
        }
    }
};
struct EpiGate3 {
    static constexpr bool PERM = true, AFTER_DRAIN = false; static constexpr int MIDK = 16;
    const bf16_t* G; bf16_t* MB;
    __device__ __forceinline__ void mid(f32x4 (&acc)[2][2][4][2], const Unit& u, int wr, int wc, int fr, int fq, int seg) const {
        asm volatile("" : "+v"(fr), "+v"(fq));
        const int row0 = u.pm * BM + wr * 64 + fr, col0 = u.pn * BM + wc * 32 + 8 * fq; const bf16_t* Ga = G + (size_t)(seg - 1) * DM, * Gb = G + (size_t)seg * DM;
#pragma unroll
        for (int ai = 0; ai < 2; ++ai) { u32x4 ga[4][2], gb[4][2];
#pragma unroll
            for (int m = 0; m < 4; ++m)
#pragma unroll
                for (int bj = 0; bj < 2; ++bj) { const size_t o = (size_t)(row0 + ai * HALF + m * 16) * LD + col0 + bj * HALF; ga[m][bj] = *(const u32x4*)(Ga + o); gb[m][bj] = *(const u32x4*)(Gb + o); }
            asm volatile("" ::: "memory");
#pragma unroll
            for (int m = 0; m < 4; ++m)
#pragma unroll
                for (int bj = 0; bj < 2; ++bj) { const u32x4 a = ga[m][bj], b = gb[m][bj];
                    const f32x4 r0 = {bflo(a.x) * fast_rcp(bflo(b.x)), bfhi(a.x) * fast_rcp(bfhi(b.x)), bflo(a.y) * fast_rcp(bflo(b.y)), bfhi(a.y) * fast_rcp(bfhi(b.y))};
                    const f32x4 r1 = {bflo(a.z) * fast_rcp(bflo(b.z)), bfhi(a.z) * fast_rcp(bfhi(b.z)), bflo(a.w) * fast_rcp(bflo(b.w)), bfhi(a.w) * fast_rcp(bfhi(b.w))};
                    acc[ai][bj][m][0] *= r0; acc[ai][bj][m][1] *= r1; }
            asm volatile("" ::: "memory"); }
    }
    __device__ __forceinline__ void operator()(const f32x4 (&acc)[2][2][4][2], const Unit& u, int wr, int wc, int fr, int fq) const {
        const int row0 = u.pm * BM + wr * 64 + fr, col0 = u.pn * BM + wc * 32 + 8 * fq; const bf16_t* G2 = G + (size_t)2 * DM;
#pragma unroll
        for (int ai = 0; ai < 2; ++ai) { u32x4 gg[4][2];
#pragma unroll
            for (int m = 0; m < 4; ++m)
#pragma unroll
                for (int bj = 0; bj < 2; ++bj) gg[m][bj] = *(const u32x4*)(G2 + (size_t)(row0 + ai * HALF + m * 16) * LD + col0 + bj * HALF);
            asm volatile("" ::: "memory");
#pragma unroll
            for (int m = 0; m < 4; ++m)
#pragma unroll
                for (int bj = 0; bj < 2; ++bj) { const u32x4 gw = gg[m][bj];
                    const f32x4 g0 = {bflo(gw.x), bfhi(gw.x), bflo(gw.y), bfhi(gw.y)}, g1 = {bflo(gw.z), bfhi(gw.z), bflo(gw.w), bfhi(gw.w)};
                    const f32x4 v0 = acc[ai][bj][m][0] * g0, v1 = acc[ai][bj][m][1] * g1;
                    u32x4 w; w.x = cvt_pk_bf16(v0[0], v0[1]); w.y = cvt_pk_bf16(v0[2], v0[3]); w.z = cvt_pk_bf16(v1[0], v1[1]); w.w = cvt_pk_bf16(v1[2], v1[3]);
                    *(u32x4*)(MB + (size_t)(row0 + ai * HALF + m * 16) * DM + col0 + bj * HALF) = w; }
            asm volatile("" ::: "memory"); }
    }
};
struct EpiResid {
    static constexpr bool PERM = false, AFTER_DRAIN = false; static constexpr int MIDK = 0;
    const float* src; float* out;
    const PG8_LAS float* ng  ; bf16_t* XB; unsigned char* XB8; float* SSQ;
    __device__ __forceinline__ void operator()(const f32x4 (&acc)[2][2][4][2], const Unit& u, int wr, int wc, int fr, int fq) const {
        const int row0 = u.pm * BM + wr * 64 + fr, col0 = u.pn * BM + wc * 32 + 4 * fq; const bool nx = XB != nullptr;
        const int lane = fr + 16 * fq;
#pragma unroll
        for (int ai = 0; ai < 2; ++ai) { f32x4 sv[4][2][2];
#pragma unroll
            for (int m = 0; m < 4; ++m)
#pragma unroll
                for (int bj = 0; bj < 2; ++bj)
#pragma unroll
                    for (int n = 0; n < 2; ++n) sv[m][bj][n] = *(const f32x4*)(src + (size_t)(row0 + ai * HALF + m * 16) * DM + col0 + bj * HALF + n * 16);
            asm volatile("" ::: "memory");
#pragma unroll
            for (int m = 0; m < 4; ++m)
#pragma unroll
                for (int bj = 0; bj < 2; ++bj)
#pragma unroll
                    for (int n = 0; n < 2; ++n) { sv[m][bj][n] = sv[m][bj][n] + acc[ai][bj][m][n]; *(f32x4*)(out + (size_t)(row0 + ai * HALF + m * 16) * DM + col0 + bj * HALF + n * 16) = sv[m][bj][n]; }
            asm volatile("" ::: "memory");
            if (nx) {
#pragma unroll
                for (int m = 0; m < 4; ++m) { float sq = 0.f;
#pragma unroll
                    for (int bj = 0; bj < 2; ++bj)
#pragma unroll
                        for (int n = 0; n < 2; ++n) { const f32x4 r = sv[m][bj][n]; const size_t o = (size_t)(row0 + ai * HALF + m * 16) * DM + col0 + bj * HALF + n * 16;
                            sq += (r[0] * r[0] + r[1] * r[1]) + (r[2] * r[2] + r[3] * r[3]); const f32x4 y = r * *(const PG8_LAS f32x4*)(ng + col0 + bj * HALF + n * 16);
                            typedef unsigned u32x2_t __attribute__((ext_vector_type(2)));
                            *(u32x2_t*)(XB + o) = (u32x2_t){cvt_pk_bf16(y[0], y[1]), cvt_pk_bf16(y[2], y[3])};
                            if (XB8) *(unsigned*)(XB8 + o) = cvt_pk4_fp8(__builtin_amdgcn_fmed3f(y[0], -448.f, 448.f), __builtin_amdgcn_fmed3f(y[1], -448.f, 448.f), __builtin_amdgcn_fmed3f(y[2], -448.f, 448.f), __builtin_amdgcn_fmed3f(y[3], -448.f, 448.f)); }
                    sq += xshf(sq, 16, lane); sq += xshf(sq, 32, lane);
                    if (fq == 0) SSQ[(size_t)(row0 + ai * HALF + m * 16) * 32 + (u.pn & 7) * 4 + wc] = sq; }
                asm volatile("" ::: "memory"); } }
    }
};
struct EpiSwiglu {
    static constexpr bool PERM = true, AFTER_DRAIN = false; static constexpr int MIDK = 0;
    bf16_t* O; int ldo, nper; const PG8_LAS float* rs; int rbase;
    __device__ __forceinline__ void operator()(const f32x4 (&acc)[2][2][4][2], const Unit& u, int wr, int wc, int fr, int fq) const {
        const int row0 = u.pm * BM + wr * 64 + fr, col0 = (u.pn % nper) * HALF + wc * 32 + 8 * fq;
#pragma unroll
        for (int ai = 0; ai < 2; ++ai)
#pragma unroll
            for (int m = 0; m < 4; ++m) { bf16_t* rowp = O + (size_t)(row0 + ai * HALF + m * 16) * ldo + col0; const float rr = rs ? rs[(row0 + ai * HALF + m * 16 - rbase) & 2047] : 1.0f;
                f32x4 v0, v1;
#pragma unroll
                for (int j = 0; j < 4; ++j) { const float a = acc[ai][0][m][0][j] * rr, b = acc[ai][0][m][1][j] * rr;
                    v0[j] = a * sigmoidf_(a) * (acc[ai][1][m][0][j] * rr); v1[j] = b * sigmoidf_(b) * (acc[ai][1][m][1][j] * rr); }
                u32x4 w; w.x = cvt_pk_bf16(v0[0], v0[1]); w.y = cvt_pk_bf16(v0[2], v0[3]); w.z = cvt_pk_bf16(v1[0], v1[1]); w.w = cvt_pk_bf16(v1[2], v1[3]);
                *(u32x4*)rowp = w; }
    }
};
struct EpiSwigluF8 {
    static constexpr bool PERM = true, AFTER_DRAIN = false; static constexpr int MIDK = 0;
    unsigned char* O; int ldo, nper;
    static __device__ __forceinline__ float act(float G, float U) { constexpr float ka = -LOG2E / F8_WSCALE, ki = F8_WSCALE * F8_WSCALE / F8_ASCALE;
        return __builtin_amdgcn_fmed3f((G * U) * fast_rcp(__builtin_fmaf(fast_exp2(G * ka), ki, ki)), -448.f, 448.f); }
    __device__ __forceinline__ void operator()(const f32x4 (&acc)[2][2][4][2], const Unit& u, int wr, int wc, int fr, int fq) const {
        asm volatile("" : "+v"(fr), "+v"(fq));
        const int row0 = u.pm * BM + wr * 64 + fr, col0 = (u.pn % nper) * HALF + wc * 32 + 8 * fq;
#pragma unroll
        for (int ai = 0; ai < 2; ++ai)
#pragma unroll
            for (int m = 0; m < 4; ++m) { unsigned char* rowp = O + (size_t)(row0 + ai * HALF + m * 16) * ldo + col0;
                f32x4 v0, v1;
#pragma unroll
                for (int j = 0; j < 4; ++j) { v0[j] = act(acc[ai][0][m][0][j], acc[ai][1][m][0][j]); v1[j] = act(acc[ai][0][m][1][j], acc[ai][1][m][1][j]); }
                typedef unsigned u32x2_t __attribute__((ext_vector_type(2)));
                *(u32x2_t*)rowp = (u32x2_t){cvt_pk4_fp8(v0[0], v0[1], v0[2], v0[3]), cvt_pk4_fp8(v1[0], v1[1], v1[2], v1[3])}; }
    }
};
struct EpiBf16Slot {
    static constexpr bool PERM = true, AFTER_DRAIN = false; static constexpr int MIDK = 0;
    bf16_t* Y; bf16_t* PART; float sc;
    __device__ __forceinline__ void operator()(const f32x4 (&acc)[2][2][4][2], const Unit& u, int wr, int wc, int fr, int fq) const {
        const bool part = u.z != 0; asm volatile("" : "+v"(fr), "+v"(fq));
        const int row0 = (part ? 0 : u.pm * BM) + wr * 64 + fr, col0 = (part ? 0 : (u.pn & 7) * BM) + wc * 32 + 8 * fq; const int ldy = part ? BM : DM;
        bf16_t* base = part ? PART + (size_t)(u.z - 1) * (BM * BM) : Y;
#pragma unroll
        for (int ai = 0; ai < 2; ++ai)
#pragma unroll
            for (int m = 0; m < 4; ++m) { bf16_t* rowp = base + (size_t)(row0 + ai * HALF + m * 16) * ldy + col0;
#pragma unroll
                for (int bj = 0; bj < 2; ++bj) { const f32x4 v0 = acc[ai][bj][m][0] * sc, v1 = acc[ai][bj][m][1] * sc;
                    u32x4 w; w.x = cvt_pk_bf16(v0[0], v0[1]); w.y = cvt_pk_bf16(v0[2], v0[3]); w.z = cvt_pk_bf16(v1[0], v1[1]); w.w = cvt_pk_bf16(v1[2], v1[3]);
                    *(u32x4*)(rowp + bj * HALF) = w; } }
    }
};
struct MoeOrder {
    int nN, nwg, G, c, ntiles, full, rem, ks, ksl, ntl; int cum[9];
    __device__ __forceinline__ void init(const int* tiles  , int nN_, int G_, int c_, bool tsplit = false, int K = 0) {
#pragma unroll
        for (int e = 0; e < 9; ++e) cum[e] = __builtin_amdgcn_readfirstlane(tiles[e]);
        ntiles = cum[8]; nN = nN_; nwg = ntiles * nN; G = G_; c = c_; full = nwg / G; rem = nwg - full * G;
        ks = tsplit ? tail_split(rem, G, K) : 1;
        ksl = K / ks; ntl = ksl / BK; }
    static __device__ __forceinline__ int tail_split(int rem, int G, int K) {
        if (rem <= 0) return 1;
        if (8 * rem <= G && K % (8 * 128) == 0) return 8; if (4 * rem <= G && K % (4 * 128) == 0) return 4; if (2 * rem <= G && K % (2 * 128) == 0) return 2; return 1; }
    __device__ __forceinline__ void tile_of(int L, int& pm, int& pn) const {
        const int nig = WGM * nN, gid = L / nig, fm = gid * WGM, gsz = (ntiles - fm) < WGM ? (ntiles - fm) : WGM;
        pm = fm + ((L % nig) % gsz); const int pnl = (L % nig) / gsz; int e = 0;
#pragma unroll
        for (int k = 1; k < 8; ++k) e += (pm >= cum[k]) ? 1 : 0;
        pn = e * nN + pnl; }
    __device__ __forceinline__ bool next(int i, Unit& u) const {
        if (i < full || ks == 1) { int cc = c; if (G == 256) { const int x = c & 7, j = c >> 3; cc = ((4 * x + (j >> 3)) << 3) + (j & 7); }
            const long L = (long)i * G + cc; if (L >= nwg) return false; tile_of((int)L, u.pm, u.pn); u.koff = 0; u.nt = 0; u.z = 0; return true; }
        if (i > full || c >= ks * rem) return false;
        const int ti = c / ks, kh = c - ti * ks; tile_of(full * G + ti, u.pm, u.pn); u.koff = kh * ksl; u.nt = ntl; u.z = 1 + c; return true;
    }
    __device__ __forceinline__ void a_ready(const Unit&) const {}
    __device__ __forceinline__ void done(const Unit&) const {}
};
}

struct Args { const void* in[20]; float* out; unsigned char* ws; int ph_lo, ph_hi; };
struct Frame {
    LAS unsigned char* lds; int tid, lane, wave, G, bx;
    unsigned char* ws;
};

struct MapId { __device__ __forceinline__ int operator()(int n) const { return n; } };
struct MapWin { __device__ __forceinline__ int operator()(int s) const {
    if (s < 2048) { const int d = s & 127; return 6144 + (s & ~127) + 8 * ((d & 63) >> 2) + 4 * (d >> 6) + (d & 3); }
    return s < SRC_GATES ? s + 6144 : s - SRC_GATES; } };
struct MapSwi { int add; __device__ __forceinline__ int operator()(int j) const { return ((j >> 7) << 8) + (j & 127) + add; } };
template <class Map>
__device__ __forceinline__ void conv_item(const float* W, int N, int kb, int nb, bf16* WT, int Kd, const Map& map, int lane, unsigned char* W8 = nullptr, int f8from = 0x7fffffff, unsigned char* W8b = nullptr, int f8b_lo = 0x7fffffff, int f8b_hi = 0x7fffffff) {
    const int k0 = 64 * kb + 16 * (lane >> 4), n = 64 * nb + 4 * (lane & 15); const bool ok = n < N;
    f32x4 v[16];
    const float* src = W + (size_t)k0 * N + (ok ? n : 0);
#pragma unroll
    for (int i = 0; i < 16; ++i) v[i] = __builtin_nontemporal_load((const f32x4*)(src + (size_t)i * N));
    const bool inb = n >= f8b_lo && n < f8b_hi;
    if (ok && (n >= f8from || inb)) { unsigned char* w8 = inb ? W8b : W8; const int r8 = inb ? n - f8b_lo : n - f8from;
#define F8W(x) __builtin_amdgcn_fmed3f((x) * pg8::F8_WSCALE, -448.f, 448.f)
#pragma unroll
        for (int j = 0; j < 4; ++j) *(u32x4*)(w8 + (size_t)(r8 + j) * Kd + k0) = (u32x4){pg8::cvt_pk4_fp8(F8W(v[0][j]), F8W(v[1][j]), F8W(v[2][j]), F8W(v[3][j])), pg8::cvt_pk4_fp8(F8W(v[4][j]), F8W(v[5][j]), F8W(v[6][j]), F8W(v[7][j])),
            pg8::cvt_pk4_fp8(F8W(v[8][j]), F8W(v[9][j]), F8W(v[10][j]), F8W(v[11][j])), pg8::cvt_pk4_fp8(F8W(v[12][j]), F8W(v[13][j]), F8W(v[14][j]), F8W(v[15][j]))};
#undef F8W
    } else if (ok) {
#pragma unroll
        for (int j = 0; j < 4; ++j) { bf16* dst = WT + (size_t)map(n + j) * Kd + k0;
            *(u32x4*)dst = (u32x4){pk2(v[0][j], v[1][j]), pk2(v[2][j], v[3][j]), pk2(v[4][j], v[5][j]), pk2(v[6][j], v[7][j])};
            *(u32x4*)(dst + 8) = (u32x4){pk2(v[8][j], v[9][j]), pk2(v[10][j], v[11][j]), pk2(v[12][j], v[13][j]), pk2(v[14][j], v[15][j])}; } }
}
template <class Map>
__device__ __forceinline__ void conv_seg(const Frame& F, const float* src, int nmat, int K, int N, bf16* dst, size_t dstride, const Map& map, int Kd = 0, unsigned char* dst8 = nullptr, size_t dstride8 = 0, int f8from = 0x7fffffff, unsigned char* dst8b = nullptr, size_t dstride8b = 0, int f8b_lo = 0x7fffffff, int f8b_hi = 0x7fffffff) {
    if (Kd == 0) Kd = K;
    const int gw = F.bx * NWAVES + F.wave, NGW = F.G * NWAVES;
    const int nkb = K / 64, nnb = (N + 63) / 64, per = nkb * nnb, total = nmat * per;
    for (int it = gw; it < total; it += NGW) { const int mat = it / per, r = it - mat * per, kb = r / nnb, nb = r - kb * nnb;
        conv_item(src + (size_t)mat * K * N, N, kb, nb, dst + (size_t)mat * dstride, Kd, map, F.lane, dst8 ? dst8 + (size_t)mat * dstride8 : nullptr, f8from, dst8b ? dst8b + (size_t)mat * dstride8b : nullptr, f8b_lo, f8b_hi); }
}
constexpr int CVM_PER = 8 * 32 * 112, CVM_TOTAL = 3 * CVM_PER, CVM_BG = 65536, CVM_LAYER = 32768, CVM_SEL = 0, CVM_KV = 16384, CVM_RET = 24576;
static_assert(CVM_BG <= CVM_TOTAL && 2 * CVM_LAYER == CVM_BG && CVM_RET + 1024 * 8 == CVM_LAYER && CVM_KV + 1024 * 8 == CVM_RET && CVM_KV == T, "background conversion slots");
struct CvmCtx { const float* w1; const float* w3; const float* w2; unsigned char* m13; unsigned char* m2; };
struct CvmLane { const float* src; unsigned char* dst; int N, Kd; };
__device__ __forceinline__ CvmLane cvm_lane(const CvmCtx& c, int id  , int lane) {
    const int seg = id / CVM_PER, r = id - seg * CVM_PER, mat = r / 3584, r2 = r - mat * 3584; CvmLane L;
    if (seg < 2) { const int kb = r2 / 112, nb = r2 - kb * 112, k0 = 64 * kb + 16 * (lane >> 4), n = 64 * nb + 4 * (lane & 15);
        L.N = DFFE; L.Kd = DM; L.src = (seg ? c.w3 : c.w1) + (size_t)mat * DM * DFFE + (size_t)k0 * DFFE + n;
        L.dst = c.m13 + (size_t)mat * 2 * DFFE * DM + (size_t)(((n >> 7) << 8) + (n & 127) + (seg ? 128 : 0)) * DM + k0; }
    else { const int kb = r2 >> 5, nb = r2 & 31, k0 = 64 * kb + 16 * (lane >> 4), n = 64 * nb + 4 * (lane & 15);
        L.N = DM; L.Kd = DFFE; L.src = c.w2 + (size_t)mat * DFFE * DM + (size_t)k0 * DM + n; L.dst = c.m2 + (size_t)mat * DM * DFFE + (size_t)n * DFFE + k0; }
    return L;
}
template <int H> __device__ __forceinline__ void cvm_load(const CvmLane& L, f32x4 (&v)[8]) {
#pragma unroll
    for (int i = 0; i < 8; ++i) v[i] = __builtin_nontemporal_load((const f32x4*)(L.src + (size_t)(8 * H + i) * L.N));
}
template <int H> __device__ __forceinline__ void cvm_store(const CvmLane& L, const f32x4 (&v)[8]) {
#pragma unroll
    for (int j = 0; j < 4; ++j) { constexpr float w = pg8::F8_WSCALE;
#define F8W(x) __builtin_amdgcn_fmed3f((x) * w, -448.f, 448.f)
        *(u32x2*)(L.dst + (size_t)j * L.Kd + 8 * H) = (u32x2){pg8::cvt_pk4_fp8(F8W(v[0][j]), F8W(v[1][j]), F8W(v[2][j]), F8W(v[3][j])), pg8::cvt_pk4_fp8(F8W(v[4][j]), F8W(v[5][j]), F8W(v[6][j]), F8W(v[7][j]))}; }
#undef F8W
}

__device__ __forceinline__ void ph_prologue(const Frame& F, const Args& a) {
    unsigned char* ws = F.ws;
    conv_seg(F, (const float*)a.in[5], 2, DM, IN_COLS, (bf16*)(ws + WS_WIN), (size_t)LD * DM, MapWin{}, 0, ws + WS_WIN8, (size_t)6144 * DM, SRC_GATES, ws + WS_WIN, (size_t)LD * DM * 2, C_AQ - 6144, C_AQ - 6144 + 3072);
    for (int l = 0; l < 2; ++l)
        conv_seg(F, (const float*)a.in[6] + (size_t)l * 3 * MIXW * DM, 3, MIXW, DM, (bf16*)(ws + WS_WBR) + (size_t)l * DM * 3 * MIXW, (size_t)MIXW, MapId{}, 3 * MIXW);
    conv_seg(F, (const float*)a.in[7], 2, DM, DM, (bf16*)(ws + WS_WO), (size_t)DM * DM, MapId{});
    conv_seg(F, (const float*)a.in[13], 1, DM, DFF, (bf16*)(ws + WS_W13), 0, MapSwi{0});
    conv_seg(F, (const float*)a.in[14], 1, DM, DFF, (bf16*)(ws + WS_W13), 0, MapSwi{128});
    conv_seg(F, (const float*)a.in[15], 1, DFF, DM, (bf16*)(ws + WS_W2), 0, MapId{});
    { const CvmCtx cc{(const float*)a.in[17], (const float*)a.in[18], (const float*)a.in[19], ws + WS_M13, ws + WS_M2};
      const int gw = F.bx * NWAVES + F.wave, NGW = F.G * NWAVES;
      for (int id = CVM_BG + gw; id < CVM_TOTAL; id += NGW) { const CvmLane L = cvm_lane(cc, id, F.lane); f32x4 v0[8], v1[8]; cvm_load<0>(L, v0); cvm_load<1>(L, v1); cvm_store<0>(L, v0); cvm_store<1>(L, v1); } }
    const int gt = F.bx * NTHREADS + F.tid, NGT = F.G * NTHREADS;
    for (int l = 0; l < 2; ++l) { u32x4* p = (u32x4*)((bf16*)(ws + WS_WIN) + (size_t)l * LD * DM + (size_t)IN_COLS * DM);
        for (int i = gt; i < (LD - IN_COLS) * DM / 8; i += NGT) p[i] = (u32x4){0u, 0u, 0u, 0u}; }
    const int* pos = (const int*)a.in[1];
    { const int gw = F.bx * NWAVES + F.wave, NGW = F.G * NWAVES;
      for (int blk = gw; blk < T / 64; blk += NGW) { int v = pos[blk * 64 + F.lane], mn = v, mx = v;
#pragma unroll
          for (int o = 1; o < 64; o <<= 1) { const int a1 = xshf_i(mn, o, F.lane), b1 = xshf_i(mx, o, F.lane); mn = a1 < mn ? a1 : mn; mx = b1 > mx ? b1 : mx; }
          if (F.lane == 0) { ((int*)(ws + WS_MISC + MS_POSMIN))[blk] = mn; ((int*)(ws + WS_MISC + MS_POSMAX))[blk] = mx; } } }
    const float* rb = (const float*)a.in[2];
    if (gt < NH * BIAS_PITCH) { const int h = gt / BIAS_PITCH, d = gt % BIAS_PITCH; int bucket;
        if (d < 16) bucket = d; else { const float v = logf((float)d / 16.0f) / 2.0794415416798357f * 16.0f; bucket = 16 + (int)v; bucket = bucket > 31 ? 31 : bucket; }
        if (d > 128) bucket = 31;
        ((float*)(ws + WS_MISC + MS_BIAS))[gt] = rb[bucket * NH + h] * LOG2E; }
    if (F.bx == 0 && F.wave == 0) {
        float mb = 0.f;
#pragma unroll
        for (int i = 0; i < 4; ++i) mb = fmaxf(mb, fabsf(rb[F.lane * 4 + i]));
#pragma unroll
        for (int o = 1; o < 64; o <<= 1) mb = fmaxf(mb, xshf(mb, o, F.lane));
        for (int l = 0; l < 2; ++l) { const float* qn = (const float*)a.in[11] + l * DH; const float* kn = (const float*)a.in[12] + l * DH;
            float mq = fmaxf(fabsf(qn[F.lane]), fabsf(qn[F.lane + 64])), mk = fmaxf(fabsf(kn[F.lane]), fabsf(kn[F.lane + 64]));
#pragma unroll
            for (int o = 1; o < 64; o <<= 1) { mq = fmaxf(mq, xshf(mq, o, F.lane)); mk = fmaxf(mk, xshf(mk, o, F.lane)); }
            if (F.lane == 0) ((float*)(ws + WS_MISC + MS_M2))[l] = (11.313708499f * mq * mk * 1.02f + mb) * LOG2E; } }
}

template <bool ROUTER>
__device__ __forceinline__ void ph_rmsnorm(const Frame& F, const float* x, const float* g, bf16* XN, const float* R  , u32x4* route, unsigned* cnt, unsigned char* XN8 = nullptr  ) {
    const int gw = F.bx * NWAVES + F.wave, NGW = F.G * NWAVES;
    volatile LAS unsigned* lcnt = (volatile LAS unsigned*)(F.lds);
    if (ROUTER) { if (F.tid < NE) lcnt[F.tid] = 0u; __syncthreads(); }
    for (int m = gw; m < T; m += NGW) {
        const f32x4* xr = (const f32x4*)(x + (size_t)m * DM) + F.lane; const f32x4* gr = (const f32x4*)g + F.lane;
        f32x4 v[8]; float ss = 0.f;
#pragma unroll
        for (int j = 0; j < 8; ++j) { v[j] = xr[64 * j]; ss += (v[j].x * v[j].x + v[j].y * v[j].y) + (v[j].z * v[j].z + v[j].w * v[j].w); }
        const float rs = 1.0f / sqrtf(wave_sum(ss, F.lane) * (1.0f / DM) + EPS);
        u32x2* o8 = (u32x2*)(XN + (size_t)m * DM) + F.lane;
        float lg[NE];
        if (ROUTER) {
#pragma unroll
            for (int e = 0; e < NE; ++e) lg[e] = 0.f; }
#pragma unroll
        for (int j = 0; j < 8; ++j) { const f32x4 gg = gr[64 * j]; const f32x4 y = v[j] * rs * gg;
            if (XN) o8[64 * j] = (u32x2){pk2(y.x, y.y), pk2(y.z, y.w)};
            if (XN8) ((unsigned*)(XN8 + (size_t)m * DM))[F.lane + 64 * j] = pg8::cvt_pk4_fp8(__builtin_amdgcn_fmed3f(y.x, -448.f, 448.f), __builtin_amdgcn_fmed3f(y.y, -448.f, 448.f), __builtin_amdgcn_fmed3f(y.z, -448.f, 448.f), __builtin_amdgcn_fmed3f(y.w, -448.f, 448.f));
            if (ROUTER) { const f32x4* rp = (const f32x4*)(R + (size_t)(4 * (F.lane + 64 * j)) * NE);
#pragma unroll
                for (int q = 0; q < 4; ++q) { const f32x4 r0 = rp[2 * q], r1 = rp[2 * q + 1]; const float yy = y[q];
                    lg[0] += yy * r0.x; lg[1] += yy * r0.y; lg[2] += yy * r0.z; lg[3] += yy * r0.w; lg[4] += yy * r1.x; lg[5] += yy * r1.y; lg[6] += yy * r1.z; lg[7] += yy * r1.w; } } }
        if (ROUTER) {
#pragma unroll
            for (int e = 0; e < NE; ++e) lg[e] = wave_sum(lg[e], F.lane);
            int e0 = 0; float v0 = lg[0];
#pragma unroll
            for (int e = 1; e < NE; ++e) if (lg[e] > v0) { v0 = lg[e]; e0 = e; }
            int e1 = -1; float v1 = -3.0e38f;
#pragma unroll
            for (int e = 0; e < NE; ++e) if (e != e0 && lg[e] > v1) { v1 = lg[e]; e1 = e; }
            const float ex = expf(v1 - v0), w0 = 1.0f / (1.0f + ex), w1 = ex / (1.0f + ex);
            if (F.lane == 0) { route[m] = (u32x4){(unsigned)e0, (unsigned)e1, __float_as_uint(w0), __float_as_uint(w1)};
                __hip_atomic_fetch_add((LAS unsigned*)lcnt + e0, 1u, __ATOMIC_RELAXED, __HIP_MEMORY_SCOPE_WORKGROUP);
                __hip_atomic_fetch_add((LAS unsigned*)lcnt + e1, 1u, __ATOMIC_RELAXED, __HIP_MEMORY_SCOPE_WORKGROUP); } }
    }
    if (ROUTER) { __syncthreads(); if (F.tid < NE) __hip_atomic_fetch_add(cnt + F.tid, lcnt[F.tid], __ATOMIC_RELAXED, __HIP_MEMORY_SCOPE_AGENT); __syncthreads(); }
}

__device__ __forceinline__ void ph_prep(const Frame& F, bf16* PROJ, const int* pos, const float* convw  , const float* qn, const float* kn) {
    const int gw = F.bx * NWAVES + F.wave, NGW = F.G * NWAVES, lane = F.lane;
    const int c0 = lane * 16;
    for (int m = gw; m < T; m += NGW) {
        bf16* P = PROJ + (size_t)m * LD; const int t = m & (SEQ - 1);
        u32x4 cc[3][2], cu[3][2];
#pragma unroll
        for (int j = 0; j < 3; ++j) { const int dt = 2 - j; const bf16* Pj = P - (size_t)(t - dt >= 0 ? dt : 0) * LD;
            cc[j][0] = *(const u32x4*)(Pj + C_CC + c0); cc[j][1] = *(const u32x4*)(Pj + C_CC + c0 + 8); cu[j][0] = *(const u32x4*)(Pj + C_CU + c0); cu[j][1] = *(const u32x4*)(Pj + C_CU + c0 + 8); }
        const u32x4 ba = *(const u32x4*)(P + C_CB + c0), bb = *(const u32x4*)(P + C_CB + c0 + 8);
        asm volatile("" ::: "memory");
        { float accv[16];
#pragma unroll
          for (int e = 0; e < 16; ++e) accv[e] = 0.f;
#pragma unroll
          for (int j = 0; j < 3; ++j) { const float on = (t - (2 - j) >= 0) ? 1.0f : 0.0f; const float* w = convw + j * MIXW + c0;
              const unsigned cw[8] = {cc[j][0].x, cc[j][0].y, cc[j][0].z, cc[j][0].w, cc[j][1].x, cc[j][1].y, cc[j][1].z, cc[j][1].w};
              const unsigned uw[8] = {cu[j][0].x, cu[j][0].y, cu[j][0].z, cu[j][0].w, cu[j][1].x, cu[j][1].y, cu[j][1].z, cu[j][1].w};
#pragma unroll
              for (int e = 0; e < 8; ++e) { accv[2 * e] += on * w[2 * e] * (bflo(cw[e]) * bflo(uw[e])); accv[2 * e + 1] += on * w[2 * e + 1] * (bfhi(cw[e]) * bfhi(uw[e])); } }
          const unsigned bw[8] = {ba.x, ba.y, ba.z, ba.w, bb.x, bb.y, bb.z, bb.w};
          unsigned ow[8];
#pragma unroll
          for (int e = 0; e < 8; ++e) ow[e] = pk2(bflo(bw[e]) * accv[2 * e], bfhi(bw[e]) * accv[2 * e + 1]);
          *(u32x4*)(P + C_CB + c0) = (u32x4){ow[0], ow[1], ow[2], ow[3]}; *(u32x4*)(P + C_CB + c0 + 8) = (u32x4){ow[4], ow[5], ow[6], ow[7]}; }
    }
}

__device__ __forceinline__ size_t sc_off(int b, int i) { return (size_t)b * SCB + (size_t)16384 * ((size_t)i * (i + 1) / 2); }
#define RELU(x) __builtin_amdgcn_fmed3f((x), 0.f, 3.0e38f)
struct IdxPos { int b, i, jj; };
__device__ __forceinline__ IdxPos idx_decode(int t) { IdxPos p; p.b = t / 4160; const int r = t - p.b * 4160;
    int i = (int)((sqrtf(4.0f * (float)r + 1.0f) - 1.0f) * 0.5f); while ((i + 1) * (i + 2) <= r) ++i; while (i * (i + 1) > r) --i; p.i = i; p.jj = r - i * (i + 1); return p; }
__device__ __forceinline__ void ph_scores(const Frame& F, const bf16* PROJ, unsigned short* SC  ) {
    const int NTILE = 2 * 4160; const int lo = (int)((long)F.bx * NTILE / F.G), hi = (int)((long)(F.bx + 1) * NTILE / F.G);
    if (lo >= hi) return;
    const int lane = F.lane, r32 = lane & 31, h2 = lane >> 5;
    IdxPos cur = idx_decode(lo);
    bf16x8 Af[4][4]; float w[4][4][4]; bf16x8 B0[2][4], B1[2][4];
#define IDX_LOADA(P_) do { const int m0_ = (P_).b * SEQ + (P_).i * 128 + F.wave * 16; \
        _Pragma("unroll") for (int rb = 0; rb < 4; ++rb) { \
            _Pragma("unroll") for (int ks = 0; ks < 4; ++ks) Af[rb][ks] = *(const bf16x8*)(PROJ + (size_t)(m0_ + 4 * rb + (r32 >> 3)) * LD + C_IQ + (r32 & 7) * 64 + 16 * ks + 8 * h2); \
            _Pragma("unroll") for (int tt = 0; tt < 4; ++tt) { const u32x2 ww = *(const u32x2*)(PROJ + (size_t)(m0_ + 4 * rb + tt) * LD + C_IW + 4 * h2); \
                w[rb][tt][0] = bflo(ww.x) * 0.04419417382415922f; w[rb][tt][1] = bfhi(ww.x) * 0.04419417382415922f; w[rb][tt][2] = bflo(ww.y) * 0.04419417382415922f; w[rb][tt][3] = bfhi(ww.y) * 0.04419417382415922f; } } } while (0)
#define IDX_LOADB(BX, P_) do { const int s0_ = (P_).b * SEQ + (P_).jj * 64; \
        _Pragma("unroll") for (int cb = 0; cb < 2; ++cb) _Pragma("unroll") for (int ks = 0; ks < 4; ++ks) BX[cb][ks] = *(const bf16x8*)(PROJ + (size_t)(s0_ + 32 * cb + r32) * LD + C_IK + 16 * ks + 8 * h2); } while (0)
#define IDX_COMPUTE(BX, P_) do { unsigned short* srow_ = SC + sc_off((P_).b, (P_).i) + (P_).jj * 64 + r32; const int rs_ = 128 * ((P_).i + 1); \
        _Pragma("unroll") for (int rb = 0; rb < 4; ++rb) _Pragma("unroll") for (int cb = 0; cb < 2; ++cb) { f32x16 d = {}; \
            _Pragma("unroll") for (int ks = 0; ks < 4; ++ks) d = __builtin_amdgcn_mfma_f32_32x32x16_bf16(Af[rb][ks], BX[cb][ks], d, 0, 0, 0); \
            float v[4]; \
            _Pragma("unroll") for (int tt = 0; tt < 4; ++tt) { v[tt] = w[rb][tt][0] * RELU(d[4 * tt]) + w[rb][tt][1] * RELU(d[4 * tt + 1]) + w[rb][tt][2] * RELU(d[4 * tt + 2]) + w[rb][tt][3] * RELU(d[4 * tt + 3]); \
                { const auto sw_ = __builtin_amdgcn_permlane32_swap(__float_as_uint(v[tt]), __float_as_uint(v[tt]), false, false); v[tt] = __uint_as_float(sw_[0]) + __uint_as_float(sw_[1]); } } \
            const float s0v = h2 ? v[2] : v[0], s1v = h2 ? v[3] : v[1]; const int tl = F.wave * 16 + 4 * rb + 2 * h2; \
            srow_[(size_t)tl * rs_ + 32 * cb] = __builtin_bit_cast(unsigned short, (_Float16)s0v); srow_[(size_t)(tl + 1) * rs_ + 32 * cb] = __builtin_bit_cast(unsigned short, (_Float16)s1v); } } while (0)
    IDX_LOADA(cur); IDX_LOADB(B0, cur);
    int t = lo;
#pragma unroll 1
    for (;;) {
        { IdxPos nx = cur; ++nx.jj; if (nx.jj == 2 * (nx.i + 1)) { nx.jj = 0; ++nx.i; if (nx.i == 64) { nx.i = 0; ++nx.b; } }
          const bool more = t + 1 < hi; if (more) IDX_LOADB(B1, nx);
          IDX_COMPUTE(B0, cur); if (!more) break;
          if (nx.jj == 0) IDX_LOADA(nx);
          cur = nx; ++t; }
        { IdxPos nx = cur; ++nx.jj; if (nx.jj == 2 * (nx.i + 1)) { nx.jj = 0; ++nx.i; if (nx.i == 64) { nx.i = 0; ++nx.b; } }
          const bool more = t + 1 < hi; if (more) IDX_LOADB(B0, nx);
          IDX_COMPUTE(B1, cur); if (!more) break;
          if (nx.jj == 0) IDX_LOADA(nx);
          cur = nx; ++t; }
    }
#undef IDX_LOADA
#undef IDX_LOADB
#undef IDX_COMPUTE
}

__device__ __forceinline__ unsigned f2key(float f) { const unsigned u = __float_as_uint(f); return u ^ ((u >> 31) ? 0xffffffffu : 0x80000000u); }
__device__ __forceinline__ int wave_sum_i(int v, int lane) { (void)lane; v = row16_sum_i(v);
    return (__builtin_amdgcn_readlane(v, 0) + __builtin_amdgcn_readlane(v, 16)) + (__builtin_amdgcn_readlane(v, 32) + __builtin_amdgcn_readlane(v, 48)); }
#define SEL_GROUPS(BODY) do { { constexpr int g = 0; BODY } if (ng > 1) { constexpr int g = 1; BODY } if (ng > 2) { constexpr int g = 2; BODY } if (ng > 3) { constexpr int g = 3; BODY } } while (0)
__device__ __forceinline__ void select_row(const unsigned short* srow, int t, u64* mcol  , int lane, LAS unsigned* scr  , const CvmLane& CL) {
    unsigned key[128];
    const int ng = (t >> 11) + 1;
    int ln = lane; asm volatile("" : "+v"(ln));
    SEL_GROUPS({ unsigned f[32];
        _Pragma("unroll") for (int q = 0; q < 32; ++q) f[q] = srow[64 * (32 * g + q) + ln];
        _Pragma("unroll") for (int q = 0; q < 32; ++q) { const int s_ = 64 * (32 * g + q) + ln; key[32 * g + q] = (f[q] ^ ((f[q] >> 15) ? 0xffffu : 0x8000u)) & ~(unsigned)((t - s_) >> 31); } });
    f32x4 cv[8]; cvm_load<0>(CL, cv);
    const int ntot = 2048 * ng;
    unsigned prefix = 0u; int c_lo = ntot, c_up = 0, bit = 15;
#pragma unroll 1
    for (; bit >= 0; --bit) {
        if (c_lo - c_up <= 64) break;
        const unsigned cand = prefix | (1u << bit); unsigned a0 = 0u, a1 = 0u;
        SEL_GROUPS({ _Pragma("unroll") for (int q = 0; q < 32; q += 2) { a0 += (key[32 * g + q] - cand) >> 31; a1 += (key[32 * g + q + 1] - cand) >> 31; } });
        const int c = ntot - wave_sum_i((int)(a0 + a1), lane);
        if (c >= 256) { prefix = cand; c_lo = c; } else c_up = c;
    }
    cvm_store<0>(CL, cv); cvm_load<1>(CL, cv);
    unsigned ck = 0u;
    if (bit >= 0) {
        const unsigned sh = (unsigned)bit + 1u, pfx = prefix >> sh; int run = 0;
        SEL_GROUPS({ _Pragma("unroll") for (int q = 0; q < 32; ++q) { const unsigned kk = key[32 * g + q]; const bool inb = (kk >> sh) == pfx; const u64 m = __ballot(inb);
            const int pos = run + (int)__builtin_amdgcn_mbcnt_hi((unsigned)(m >> 32), __builtin_amdgcn_mbcnt_lo((unsigned)m, 0u));
            if (inb) scr[pos & 63] = kk;
            run += __builtin_popcountll(m); __builtin_amdgcn_sched_barrier(0); } });
        ck = (lane < run) ? scr[lane] : 0u;
#pragma unroll 1
        for (; bit >= 0; --bit) { const unsigned cand = prefix | (1u << bit); const int c = c_up + __builtin_popcountll(__ballot(ck >= cand)); if (c >= 256) { prefix = cand; c_lo = c; } }
    }
    int cgt;
    { const unsigned cand = prefix + 1u; unsigned a0 = 0u, a1 = 0u;
      SEL_GROUPS({ _Pragma("unroll") for (int q = 0; q < 32; q += 2) { a0 += (key[32 * g + q] - cand) >> 31; a1 += (key[32 * g + q + 1] - cand) >> 31; } });
      cgt = ntot - wave_sum_i((int)(a0 + a1), lane); }
    const int need = 256 - cgt; unsigned w0l = 0u, w0h = 0u, w1l = 0u, w1h = 0u;
    unsigned pf = prefix; asm volatile("" : "+v"(pf));
#define SEL_PUT(b_, j_) do { const unsigned bl_ = (unsigned)(b_), bh_ = (unsigned)((b_) >> 32); \
        if ((j_) < 64) { asm volatile("s_nop 1\n\tv_writelane_b32 %0, %1, %2" : "+v"(w0l) : "s"(bl_), "n"((j_) & 63)); asm volatile("s_nop 1\n\tv_writelane_b32 %0, %1, %2" : "+v"(w0h) : "s"(bh_), "n"((j_) & 63)); } \
        else { asm volatile("s_nop 1\n\tv_writelane_b32 %0, %1, %2" : "+v"(w1l) : "s"(bl_), "n"((j_) & 63)); asm volatile("s_nop 1\n\tv_writelane_b32 %0, %1, %2" : "+v"(w1h) : "s"(bh_), "n"((j_) & 63)); } } while (0)
    if (c_lo - cgt == need) {
        SEL_GROUPS({ _Pragma("unroll") for (int q = 0; q < 32; ++q) { const u64 b = __ballot(key[32 * g + q] >= pf); SEL_PUT(b, 32 * g + q); __builtin_amdgcn_sched_barrier(0); } });
    } else { int run = 0;
        SEL_GROUPS({ _Pragma("unroll") for (int q = 0; q < 32; ++q) { const unsigned kk = key[32 * g + q]; const u64 beq = __ballot(kk == pf);
            const int below = (int)__builtin_amdgcn_mbcnt_hi((unsigned)(beq >> 32), __builtin_amdgcn_mbcnt_lo((unsigned)beq, 0u));
            const bool sel = (kk > pf) || (kk == pf && run + below < need);
            const u64 b = __ballot(sel); run += __builtin_popcountll(beq); SEL_PUT(b, 32 * g + q); __builtin_amdgcn_sched_barrier(0); } }); }
#undef SEL_PUT
    mcol[(size_t)lane * SEQ] = ((u64)w0h << 32) | w0l; mcol[(size_t)(lane + 64) * SEQ] = ((u64)w1h << 32) | w1l;
    cvm_store<1>(CL, cv);
}
__device__ __forceinline__ void ph_select(const Frame& F, const unsigned short* SC, u64* MASK, const CvmCtx& cc, int cvbase) {
    const int gw = F.bx * NWAVES + F.wave, NGW = F.G * NWAVES, lane = F.lane;
    for (int m = gw; m < T; m += NGW) { const int b = m >> 13, t = m & (SEQ - 1), i = t >> 7, nch = 2 * (i + 1);
        u64* mcol = MASK + (size_t)b * 128 * SEQ + t; const CvmLane CL = cvm_lane(cc, cvbase + CVM_SEL + m, lane);
        if (t < 256) {
            u64 w[2];
#pragma unroll
            for (int q = 0; q < 2; ++q) { const int j = lane + 64 * q; const int rem = t - 64 * j + 1;
                w[q] = rem <= 0 ? 0ull : (rem >= 64 ? ~0ull : ((1ull << rem) - 1ull)); }
            mcol[(size_t)lane * SEQ] = w[0]; mcol[(size_t)(lane + 64) * SEQ] = w[1];
            f32x4 v0[8], v1[8]; cvm_load<0>(CL, v0); cvm_load<1>(CL, v1); cvm_store<0>(CL, v0); cvm_store<1>(CL, v1);
        } else {
            const unsigned short* srow = SC + sc_off(b, i) + (size_t)(t & 127) * (128 * (i + 1));
            LAS unsigned* scr = (LAS unsigned*)(F.lds + F.wave * 256);
            select_row(srow, t, mcol, lane, scr, CL);
        } }
}

constexpr int TRS = 272;
typedef short v4i16_t __attribute__((ext_vector_type(4)));
__device__ __forceinline__ s16x4 ldtr(LAS const unsigned char* p) { return __builtin_bit_cast(s16x4, __builtin_amdgcn_ds_read_tr16_b64_v4i16((LAS v4i16_t*)p)); }
__device__ __forceinline__ bf16x8 cat8(s16x4 a, s16x4 b) { return (bf16x8){a[0], a[1], a[2], a[3], b[0], b[1], b[2], b[3]}; }
template <bool SCALE>
__device__ __forceinline__ void stage_tile(LAS unsigned char* tile, const bf16* g, int tid, float lg) {
    const int row = tid >> 2, cq = (tid & 3) * 32; const bf16* p = g + (size_t)row * LD + cq;
    u32x4 v[4];
#pragma unroll
    for (int i = 0; i < 4; ++i) v[i] = *(const u32x4*)(p + 8 * i);
    if (SCALE) { const float sc = fast_exp2((float)(127 - row) * lg);
#pragma unroll
        for (int i = 0; i < 4; ++i) { v[i].x = pk2(bflo(v[i].x) * sc, bfhi(v[i].x) * sc); v[i].y = pk2(bflo(v[i].y) * sc, bfhi(v[i].y) * sc);
            v[i].z = pk2(bflo(v[i].z) * sc, bfhi(v[i].z) * sc); v[i].w = pk2(bflo(v[i].w) * sc, bfhi(v[i].w) * sc); } }
#pragma unroll
    for (int i = 0; i < 4; ++i) *(LAS u32x4*)(tile + row * TRS + (cq + 8 * i) * 2) = v[i];
}
__device__ __forceinline__ void kv_unit(const Frame& F, const bf16* PROJ, float* KVS, int u, const CvmCtx& cc, int cvbase) {
    const CvmLane CL = cvm_lane(cc, cvbase + CVM_KV + u * NWAVES + F.wave, F.lane); f32x4 cv0[8], cv1[8];
    const int h = u & 7, bn = u >> 3, m0 = bn * 128;
    const float lg = log2gamma(h);
    LAS unsigned char* Vt = F.lds, * Kt = F.lds + 128 * TRS;
    stage_tile<false>(Vt, PROJ + (size_t)m0 * LD + C_RV + h * DH, F.tid, 0.f);
    stage_tile<true>(Kt, PROJ + (size_t)m0 * LD + C_RK + h * DH, F.tid, lg);
    cvm_load<0>(CL, cv0); cvm_load<1>(CL, cv1);
    asm volatile("s_waitcnt lgkmcnt(0)\n\ts_barrier" ::: "memory");
    const int lane = F.lane, i16 = lane & 15, g = lane >> 4, qq = i16 >> 2, p4 = (i16 & 3) * 4, w = F.wave;
    f32x4 acc[8];
#pragma unroll
    for (int dt = 0; dt < 8; ++dt) acc[dt] = (f32x4){0.f, 0.f, 0.f, 0.f};
#pragma unroll
    for (int s = 0; s < 4; ++s) {
        const int r0 = 32 * s + 8 * g + qq;
        const bf16x8 af = cat8(ldtr(Vt + r0 * TRS + (16 * w + p4) * 2), ldtr(Vt + (r0 + 4) * TRS + (16 * w + p4) * 2));
#pragma unroll
        for (int dt = 0; dt < 8; ++dt) { const bf16x8 bfr = cat8(ldtr(Kt + r0 * TRS + (16 * dt + p4) * 2), ldtr(Kt + (r0 + 4) * TRS + (16 * dt + p4) * 2));
            acc[dt] = __builtin_amdgcn_mfma_f32_16x16x32_bf16(af, bfr, acc[dt], 0, 0, 0); } }
    float* out = KVS + (size_t)u * 16384;
#pragma unroll
    for (int dt = 0; dt < 8; ++dt)
#pragma unroll
        for (int r = 0; r < 4; ++r) out[(16 * w + 4 * g + r) * 128 + 16 * dt + i16] = acc[dt][r];
    cvm_store<0>(CL, cv0); cvm_store<1>(CL, cv1);
    asm volatile("s_waitcnt lgkmcnt(0)\n\ts_barrier" ::: "memory");
}
__device__ __forceinline__ void ph_scan(const Frame& F, float* KVS) {
    const int gt = F.bx * NTHREADS + F.tid, NGT = F.G * NTHREADS;
    for (int c = gt; c < NB * NH * 16384; c += NGT) { const int bh = c >> 14, ed = c & 16383, b = bh >> 3, h = bh & 7;
        const float cd = exp2f(128.0f * log2gamma(h)); float* p = KVS + ((size_t)(b * 64) * 8 + h) * 16384 + ed; float s = 0.f;
#pragma unroll 1
        for (int n0 = 0; n0 < 64; n0 += 16) { float v[16];
#pragma unroll
            for (int q = 0; q < 16; ++q) v[q] = p[(size_t)(n0 + q) * 8 * 16384];
#pragma unroll
            for (int q = 0; q < 16; ++q) { p[(size_t)(n0 + q) * 8 * 16384] = s; s = s * cd + v[q]; } } }
}
__device__ __forceinline__ void ret_unit(const Frame& F, bf16* PROJ, const float* KVS, const float* gnw, const float* gnb, int u, const CvmCtx& cc, int cvbase) {
    const CvmLane CL = cvm_lane(cc, cvbase + CVM_RET + u * NWAVES + F.wave, F.lane); f32x4 cv0[8], cv1[8];
    const int h = u & 7, bn = u >> 3, m0 = bn * 128; const float lg = log2gamma(h);
    LAS unsigned char* Kt = F.lds, * Vt = F.lds + 128 * TRS, * Pt = F.lds + 2 * 128 * TRS;
    stage_tile<false>(Kt, PROJ + (size_t)m0 * LD + C_RK + h * DH, F.tid, 0.f);
    stage_tile<false>(Vt, PROJ + (size_t)m0 * LD + C_RV + h * DH, F.tid, 0.f);
    { const int row = F.tid >> 2, cq = (F.tid & 3) * 32; const float* p = KVS + (size_t)u * 16384 + row * 128 + cq;
#pragma unroll
      for (int i = 0; i < 4; ++i) { const f32x4 a = *(const f32x4*)(p + 8 * i), b2 = *(const f32x4*)(p + 8 * i + 4);
          *(LAS u32x4*)(Pt + row * TRS + (cq + 8 * i) * 2) = (u32x4){pk2(a.x, a.y), pk2(a.z, a.w), pk2(b2.x, b2.y), pk2(b2.z, b2.w)}; } }
    cvm_load<0>(CL, cv0); cvm_load<1>(CL, cv1);
    asm volatile("s_waitcnt lgkmcnt(0)\n\ts_barrier" ::: "memory");
    const int lane = F.lane, i16 = lane & 15, g = lane >> 4, qq = i16 >> 2, p4 = (i16 & 3) * 4, w = F.wave;
    const int tl = 16 * w + i16;
    bf16x8 qf[4];
#pragma unroll
    for (int ks = 0; ks < 4; ++ks) qf[ks] = *(const bf16x8*)(PROJ + (size_t)(m0 + tl) * LD + C_RQ + h * DH + 32 * ks + 8 * g);
    bf16x8 sb[4];
#pragma unroll
    for (int s = 0; s < 4; ++s) { unsigned pw[4];
#pragma unroll
        for (int hlf = 0; hlf < 2; ++hlf) { const int jt = 2 * s + hlf; f32x4 st = {0.f, 0.f, 0.f, 0.f};
            if (jt <= w) {
#pragma unroll
                for (int ks = 0; ks < 4; ++ks) { const bf16x8 ka = *(LAS const bf16x8*)(Kt + (16 * jt + i16) * TRS + (32 * ks + 8 * g) * 2);
                    st = __builtin_amdgcn_mfma_f32_16x16x32_bf16(ka, qf[ks], st, 0, 0, 0); }
#pragma unroll
                for (int r = 0; r < 4; ++r) { const int dj = tl - (16 * jt + 4 * g + r); st[r] = dj >= 0 ? st[r] * fast_exp2((float)dj * lg) : 0.f; } }
            pw[2 * hlf] = pk2(st[0], st[1]); pw[2 * hlf + 1] = pk2(st[2], st[3]); }
        sb[s] = __builtin_bit_cast(bf16x8, (u32x4){pw[0], pw[1], pw[2], pw[3]}); }
    const float qdec = fast_exp2((float)(tl + 1) * lg);
    f32x4 o[8]; float sum = 0.f;
#pragma unroll
    for (int et = 0; et < 8; ++et) { f32x4 ai = {0.f, 0.f, 0.f, 0.f}, ac = {0.f, 0.f, 0.f, 0.f};
#pragma unroll
        for (int s = 0; s < 4; ++s) { if (2 * s <= w) { const int r0 = 32 * s + 4 * g + qq;
                const bf16x8 va = cat8(ldtr(Vt + r0 * TRS + (16 * et + p4) * 2), ldtr(Vt + (r0 + 16) * TRS + (16 * et + p4) * 2));
                ai = __builtin_amdgcn_mfma_f32_16x16x32_bf16(va, sb[s], ai, 0, 0, 0); } }
#pragma unroll
        for (int ks = 0; ks < 4; ++ks) { const bf16x8 pa = *(LAS const bf16x8*)(Pt + (16 * et + i16) * TRS + (32 * ks + 8 * g) * 2);
            ac = __builtin_amdgcn_mfma_f32_16x16x32_bf16(pa, qf[ks], ac, 0, 0, 0); }
        o[et] = ai + ac * qdec; sum += (o[et][0] + o[et][1]) + (o[et][2] + o[et][3]); }
    sum += xshf(sum, 16, lane); sum += xshf(sum, 32, lane);
    const float mean = sum * (1.0f / DH); float var = 0.f;
#pragma unroll
    for (int et = 0; et < 8; ++et)
#pragma unroll
        for (int r = 0; r < 4; ++r) { const float dlt = o[et][r] - mean; var += dlt * dlt; }
    var += xshf(var, 16, lane); var += xshf(var, 32, lane);
    const float rstd = 1.0f / sqrtf(var * (1.0f / DH) + EPS);
    bf16* yrow = PROJ + (size_t)(m0 + tl) * LD + C_RG + h * DH;
    u32x2 rgall[8];
#pragma unroll
    for (int et = 0; et < 8; ++et) rgall[et] = *(const u32x2*)(yrow + 16 * et + 4 * g);
    asm volatile("" ::: "memory");
#pragma unroll
    for (int et = 0; et < 8; ++et) { const int e0 = 16 * et + 4 * g; const u32x2 rgw = rgall[et];
        const f32x4 gw4 = *(const f32x4*)(gnw + h * DH + e0), gb4 = *(const f32x4*)(gnb + h * DH + e0);
        const float rg[4] = {bflo(rgw.x), bfhi(rgw.x), bflo(rgw.y), bfhi(rgw.y)}; float y[4];
#pragma unroll
        for (int r = 0; r < 4; ++r) { const float nv = (o[et][r] - mean) * rstd * gw4[r] + gb4[r]; y[r] = rg[r] * sigmoidf_(rg[r]) * nv; }
        *(u32x2*)(yrow + e0) = (u32x2){pk2(y[0], y[1]), pk2(y[2], y[3])}; }
    cvm_store<0>(CL, cv0); cvm_store<1>(CL, cv1);
    asm volatile("s_waitcnt lgkmcnt(0)\n\ts_barrier" ::: "memory");
}

constexpr int SHM_K = 64 * 128 * 2, SHM_V = 64 * 128 * 2;
#define KSWZ(row, colB) ((row) * 256 + ((colB) ^ (((row) & 7) << 4)))
__device__ __forceinline__ int v_st(int k, int c) { const int kk = (k & ~0xC) | ((k & 4) << 1) | ((k & 8) >> 1); return ((kk >> 3) * 4 + (c >> 5)) * 512 + ((kk & 7) * 32 + (c & 31)) * 2; }
__device__ __forceinline__ int v_rd_base(int lane) { return ((lane & 3) << 3) | (((lane >> 2) & 3) << 6) | (((lane >> 4) & 1) << 5) | (((lane >> 5) & 1) << 8); }
constexpr int v_rd_off(int d0, int ks, int half) { return d0 * 512 + ks * 4096 + half * 2048; }
__device__ __forceinline__ int crow(int r, int hi) { return (r & 3) + 8 * (r >> 2) + 4 * hi; }
#define SBAR() __builtin_amdgcn_sched_barrier(0)
template <int KB>
__device__ __forceinline__ void qkt(f32x16& p0, f32x16& p1, LAS const unsigned char* K_lds, int r32, int hi, const bf16x8* qr) {
    LAS const unsigned char* kb[4];
#pragma unroll
    for (int dd = 0; dd < 4; ++dd) kb[dd] = K_lds + KB * SHM_K + KSWZ(r32, (dd * 16 + hi * 8) * 2);
#pragma unroll
    for (int d0 = 0; d0 < 8; ++d0) { LAS const unsigned char* a = kb[d0 & 3] + (d0 >> 2) * 128;
        const bf16x8 b0 = *(LAS const bf16x8*)a, b1 = *(LAS const bf16x8*)(a + 32 * 256);
        p0 = __builtin_amdgcn_mfma_f32_32x32x16_bf16(b0, qr[d0], p0, 0, 0, 0);
        p1 = __builtin_amdgcn_mfma_f32_32x32x16_bf16(b1, qr[d0], p1, 0, 0, 0); }
}
__device__ __forceinline__ void pv_tile(f32x16* o, int vb0  , bf16x8 pa0, bf16x8 pa1, bf16x8 pa2, bf16x8 pa3) {
#define TRRD(dst, off) asm volatile("ds_read_b64_tr_b16 %0, %1 offset:%2" : "=&v"(dst) : "v"(vb0), "i"(off) : "memory")
#define PV_D0(d0) do { s16x4 l0, l1, l2, l3, h0, h1, h2, h3; constexpr int b_ = v_rd_off(d0, 0, 0); \
        TRRD(l0, b_); TRRD(h0, b_ + 2048); TRRD(l1, b_ + 4096); TRRD(h1, b_ + 6144); TRRD(l2, b_ + 8192); TRRD(h2, b_ + 10240); TRRD(l3, b_ + 12288); TRRD(h3, b_ + 14336); \
        asm volatile("s_waitcnt lgkmcnt(0)" ::: "memory"); SBAR();   \
        o[d0] = __builtin_amdgcn_mfma_f32_32x32x16_bf16(pa0, (bf16x8){l0[0], l0[1], l0[2], l0[3], h0[0], h0[1], h0[2], h0[3]}, o[d0], 0, 0, 0);   \
        o[d0] = __builtin_amdgcn_mfma_f32_32x32x16_bf16(pa1, (bf16x8){l1[0], l1[1], l1[2], l1[3], h1[0], h1[1], h1[2], h1[3]}, o[d0], 0, 0, 0);   \
        o[d0] = __builtin_amdgcn_mfma_f32_32x32x16_bf16(pa2, (bf16x8){l2[0], l2[1], l2[2], l2[3], h2[0], h2[1], h2[2], h2[3]}, o[d0], 0, 0, 0);   \
        o[d0] = __builtin_amdgcn_mfma_f32_32x32x16_bf16(pa3, (bf16x8){l3[0], l3[1], l3[2], l3[3], h3[0], h3[1], h3[2], h3[3]}, o[d0], 0, 0, 0); } while (0)
    PV_D0(0); PV_D0(1); PV_D0(2); PV_D0(3);
#undef PV_D0
#undef TRRD
}
struct AttnCtx { bf16* PROJ; const u64* MASK; const int* pos; const int* posmin; const int* posmax; const float* btab; float M2; };
__device__ __forceinline__ int bfe1(unsigned w, int pos) { int m; asm("v_bfe_i32 %0, %1, %2, 1" : "=v"(m) : "v"(w), "n"(pos)); return m; }
__device__ __forceinline__ float bsel(int m, float a, float b) { return __int_as_float((m & __float_as_int(a)) | (~m & __float_as_int(b))); }
template <bool FAR>
__device__ __forceinline__ void p_init(f32x16& p0, f32x16& p1, u64 mw, int hi, float cfar, const LAS float* tab  , int qpos, const LAS int* kpos  , float M2) {
    const unsigned wlo = (unsigned)mw >> (4 * hi), whi = (unsigned)(mw >> 32) >> (4 * hi); const float NEG = -1.0e30f;
#pragma unroll
    for (int r = 0; r < 16; ++r) { const int bp = (r & 3) + 8 * (r >> 2);
        float c0 = cfar, c1 = cfar;
        if (!FAR) { int d0 = qpos - kpos[bp + 4 * hi], d1 = qpos - kpos[bp + 4 * hi + 32]; d0 = d0 < 0 ? 0 : (d0 > 128 ? 128 : d0); d1 = d1 < 0 ? 0 : (d1 > 128 ? 128 : d1);
            c0 = tab[d0] - M2; c1 = tab[d1] - M2; }
        p0[r] = bsel(bfe1(wlo, bp), c0, NEG); p1[r] = bsel(bfe1(whi, bp), c1, NEG);
        if (!FAR && (r & 3) == 3) SBAR(); }
}
__device__ __forceinline__ float p_finish(f32x16& p0, f32x16& p1, bf16x8& pa0, bf16x8& pa1, bf16x8& pa2, bf16x8& pa3) {
    float ps = 0.f;
#pragma unroll
    for (int r = 0; r < 16; ++r) { p0[r] = fast_exp2(p0[r]); p1[r] = fast_exp2(p1[r]); ps += p0[r] + p1[r]; }
#define PK4(P, B_, OUT) do { unsigned a0 = pk2(P[B_+0], P[B_+1]), a1 = pk2(P[B_+2], P[B_+3]); unsigned b0 = pk2(P[B_+4], P[B_+5]), b1 = pk2(P[B_+6], P[B_+7]); \
        auto r0 = __builtin_amdgcn_permlane32_swap(a0, b0, false, false); auto r1 = __builtin_amdgcn_permlane32_swap(a1, b1, false, false); \
        u32x4 w = {r0[0], r1[0], r0[1], r1[1]}; OUT = __builtin_bit_cast(bf16x8, w); } while (0)
    PK4(p0, 0, pa0); PK4(p0, 8, pa1); PK4(p1, 0, pa2); PK4(p1, 8, pa3);
#undef PK4
    return ps;
}
__device__ __forceinline__ void attn_unit(const Frame& F, const AttnCtx& C, int b, int h, int qb, bool dry) {
    const int tid = F.tid, wid = F.wave, lane = F.lane, r32 = lane & 31, hi = lane >> 5;
    LAS unsigned char* V_lds = F.lds; LAS unsigned char* K_lds = F.lds + 3 * SHM_V;
    const bool late = wid >= 4;
    const int q0 = qb * 256 + wid * 32;
    const int mrow = b * SEQ + q0 + r32;
    bf16* Qp = C.PROJ + (size_t)mrow * LD + C_AQ + h * DH;
    bf16x8 qr[8];
#pragma unroll
    for (int d0 = 0; d0 < 8; ++d0) qr[d0] = *(const bf16x8*)(Qp + d0 * 16 + hi * 8);
    const int NT = 4 * (qb + 1);
    const bf16* Kg = C.PROJ + (size_t)(b * SEQ) * LD + C_AK + h * DH; const bf16* Vg = C.PROJ + (size_t)(b * SEQ) * LD + C_AV + h * DH;
    const u64* mk = C.MASK + (size_t)(b * 128) * SEQ + (q0 + r32);
    const int sr = tid >> 4, sc = (tid & 15) * 8, vst0 = v_st(sr, sc), vst1 = v_st(32 + sr, sc), kws = KSWZ(sr, sc * 2);
    const int vb0 = (int)(unsigned)(size_t)V_lds + v_rd_base(lane);
    const int qpos = C.pos[mrow]; const int qpmin = C.posmin[(b * SEQ + q0) >> 6];
    const float* tab = C.btab + h * BIAS_PITCH; const float cfar = tab[128] - C.M2;
    LAS float* tl = (LAS float*)(F.lds + 5 * SHM_V); LAS int* kl = (LAS int*)(F.lds + 5 * SHM_V + 1024); int skp = 0;
    if (tid < BIAS_PITCH) tl[tid] = tab[tid];
    float l = 0.f; f32x16 o[4] = {};
    u32x4 sk0, sk1, sv0, sv1; u64 mw, mwn = 0ull; int pmx, pmxn = 0;
#define ALOAD(t_) do { const size_t kr_ = (size_t)((t_) * 64 + sr) * LD + sc; sk0 = *(const u32x4*)(Kg + kr_); sk1 = *(const u32x4*)(Kg + kr_ + (size_t)32 * LD); if (wid == 0) skp = C.pos[b * SEQ + (t_) * 64 + lane]; \
                       sv0 = *(const u32x4*)(Vg + kr_); sv1 = *(const u32x4*)(Vg + kr_ + (size_t)32 * LD); } while (0)
#define AWRITE(bf_) do { *(LAS u32x4*)(K_lds + (bf_) * SHM_K + kws) = sk0; *(LAS u32x4*)(K_lds + (bf_) * SHM_K + kws + 32 * 256) = sk1; if (wid == 0) kl[(bf_) * 64 + lane] = skp; \
                         *(LAS u32x4*)(V_lds + vs * SHM_V + vst0) = sv0; *(LAS u32x4*)(V_lds + vs * SHM_V + vst1) = sv1; } while (0)
#define ASTEP(t_, BF_) do { AWRITE(BF_); mw = mwn; pmx = pmxn; if ((t_) + 1 < NT) { ALOAD((t_) + 1); mwn = mk[(size_t)((t_) + 1) * SEQ]; pmxn = C.posmax[(b * SEQ + ((t_) + 1) * 64) >> 6]; } \
        asm volatile("s_waitcnt lgkmcnt(0)\n\ts_barrier" ::: "memory");     \
        if (late && actprev) pv_tile(o, vb0 + vprev * SHM_V, pa0, pa1, pa2, pa3);     \
        const bool act_ = (t_) * 64 <= q0 + 31;                             \
        if (act_) { f32x16 p0, p1; \
            const bool farb = (qpmin - pmx) >= 128;                         \
            if (farb) p_init<true>(p0, p1, mw, hi, cfar, tl, qpos, kl + (BF_) * 64, C.M2); \
            else p_init<false>(p0, p1, mw, hi, cfar, tl, qpos, kl + (BF_) * 64, C.M2); \
            qkt<BF_>(p0, p1, K_lds, r32, hi, qr); \
            l += p_finish(p0, p1, pa0, pa1, pa2, pa3); \
            SBAR(); if (!late) pv_tile(o, vb0 + vs * SHM_V, pa0, pa1, pa2, pa3); } \
        actprev = act_; vprev = vs; vs = vs == 2 ? 0 : vs + 1; } while (0)
    bf16x8 pa0, pa1, pa2, pa3; int vs = 0, vprev = 0; bool actprev = false;
    ALOAD(0); mwn = mk[0]; pmxn = C.posmax[(b * SEQ) >> 6];
#pragma unroll 1
    for (int t = 0; t < NT; t += 2) { ASTEP(t, 0); ASTEP(t + 1, 1); }
    if (late && actprev) pv_tile(o, vb0 + vprev * SHM_V, pa0, pa1, pa2, pa3);
#undef ASTEP
#undef AWRITE
#undef ALOAD
    l += xshf(l, 32, lane);
    const float linv = 1.0f / l;
    int r32o = r32, hio = hi; asm volatile("" : "+v"(r32o), "+v"(hio));
    bf16* Ow = C.PROJ + (size_t)(b * SEQ + q0) * LD + C_CC + h * DH + r32o;
#pragma unroll
    for (int r = 0; r < 16; ++r) { const int orow = crow(r, hio); const float rl = lshf(linv, orow, lane);
#pragma unroll
        for (int d0 = 0; d0 < 4; ++d0) { const float v = o[d0][r] * rl; const float vn = xshf(v, 1, lane);
            if ((r32o & 1) == 0 && !dry) *(unsigned*)(Ow + (size_t)orow * LD + d0 * 32) = pk2(v, vn); } }
    __syncthreads();
}

__device__ __forceinline__ void gains_to_lds(const Frame& F, const float* g) { ((LAS f32x4*)(F.lds + pg8::STAGE_BYTES))[F.tid] = ((const f32x4*)g)[F.tid]; __syncthreads(); }
__device__ __forceinline__ void rstd_table(const Frame& F, const float* SSQ) {
    LAS float* tab = (LAS float*)(F.lds + pg8::STAGE_BYTES); const int rb = (F.bx & 7) * 2048;
#pragma unroll 1
    for (int q = 0; q < 4; ++q) { const int r = F.tid + 512 * q; const f32x4* p = (const f32x4*)(SSQ + (size_t)(rb + r) * 32); f32x4 v[8];
#pragma unroll
        for (int i = 0; i < 8; ++i) v[i] = p[i];
        float sq = 0.f;
#pragma unroll
        for (int i = 0; i < 8; ++i) sq += (v[i].x + v[i].y) + (v[i].z + v[i].w);
        tab[r] = 1.0f / sqrtf(sq * (1.0f / DM) + EPS); }
    __syncthreads();
}
__device__ __forceinline__ void ph_assign(const Frame& F, const u32x4* route, const unsigned* cnt, unsigned* cur, int* tiles  , int* tokslot  , const unsigned char* XN8  , unsigned char* HPERM  ) {
    volatile LAS int* sh = (volatile LAS int*)F.lds;
    int seg[9]; seg[0] = 0;
#pragma unroll
    for (int e = 0; e < NE; ++e) { const unsigned c = __hip_atomic_load(cnt + e, __ATOMIC_RELAXED, __HIP_MEMORY_SCOPE_AGENT); seg[e + 1] = seg[e] + (int)((c + 255u) >> 8); }
    if (F.bx == 0 && F.tid < 9) { int v = 0;
#pragma unroll
        for (int e = 0; e < 9; ++e) v = (F.tid == e) ? seg[e] : v;
        tiles[F.tid] = v; }
    for (int ch = F.bx; ch < T / 64; ch += F.G) {
        if (F.tid < NE) sh[F.tid] = 0;
        __syncthreads();
        int e = 0, rank = 0; const int tok = ch * 64 + (F.tid >> 1), k = F.tid & 1;
        if (F.tid < 128) { const u32x4 r = route[tok]; e = (int)(k ? r.y : r.x); rank = __hip_atomic_fetch_add((LAS int*)sh + e, 1, __ATOMIC_RELAXED, __HIP_MEMORY_SCOPE_WORKGROUP); }
        __syncthreads();
        if (F.tid < NE) sh[8 + F.tid] = (int)__hip_atomic_fetch_add(cur + F.tid, (unsigned)sh[F.tid], __ATOMIC_RELAXED, __HIP_MEMORY_SCOPE_AGENT);
        __syncthreads();
        if (F.tid < 128) { int sg = 0;
#pragma unroll
            for (int q = 0; q < NE; ++q) sg = (e == q) ? seg[q] : sg;
            const int slot = sg * 256 + sh[8 + e] + rank; sh[32 + F.tid] = slot; tokslot[tok * 2 + k] = slot; }
        __syncthreads();
        for (int a2 = 0; a2 < 128; a2 += 16) { u32x2 v[8]; const int piece = F.tid & 255;
#pragma unroll
            for (int q = 0; q < 8; ++q) { const int a1 = a2 + 2 * q + (F.tid >> 8); v[q] = *(const u32x2*)(XN8 + (size_t)(ch * 64 + (a1 >> 1)) * DM + piece * 8); }
#pragma unroll
            for (int q = 0; q < 8; ++q) { const int a1 = a2 + 2 * q + (F.tid >> 8); *(u32x2*)(HPERM + (size_t)sh[32 + a1] * DM + piece * 8) = v[q]; } }
        __syncthreads();
    }
}
__device__ __forceinline__ void moe_row8(const bf16* Y, const bf16* PART, int slot, int cidx, int ntiles, int tail0  , int ks, float (&v)[8]) {
    const int pm = slot >> 8, pnl = cidx >> 5, gid = pm >> 3, fm = gid * 8, gsz = (ntiles - fm) < 8 ? (ntiles - fm) : 8, L = gid * 64 + pnl * gsz + (pm - fm);
    if (L < tail0) { const u32x4 a = *(const u32x4*)(Y + (size_t)slot * DM + cidx * 8);
        v[0] = bflo(a.x); v[1] = bfhi(a.x); v[2] = bflo(a.y); v[3] = bfhi(a.y); v[4] = bflo(a.z); v[5] = bfhi(a.z); v[6] = bflo(a.w); v[7] = bfhi(a.w); }
    else {
#pragma unroll
        for (int e = 0; e < 8; ++e) v[e] = 0.f;
        for (int kh = 0; kh < ks; ++kh) { const u32x4 a = *(const u32x4*)(PART + (size_t)((L - tail0) * ks + kh) * 65536 + (slot & 255) * 256 + (cidx & 31) * 8);
            v[0] += bflo(a.x); v[1] += bfhi(a.x); v[2] += bflo(a.y); v[3] += bfhi(a.y); v[4] += bflo(a.z); v[5] += bfhi(a.z); v[6] += bflo(a.w); v[7] += bfhi(a.w); } }
}
__device__ __forceinline__ void ph_combine(const Frame& F, float* out, const bf16* Y, const bf16* PART, const u32x4* route, const int* tokslot, const int* tiles) {
    const int gw = F.bx * NWAVES + F.wave, NGW = F.G * NWAVES;
    const int ntiles = __builtin_amdgcn_readfirstlane(tiles[8]), nwg = ntiles * 8, full = nwg / F.G, rem = nwg - full * F.G;
    const int ks = pg8::MoeOrder::tail_split(rem, F.G, DFFE / 2);
    const int tail0 = ks > 1 ? full * F.G : 0x7fffffff;
    for (int m = gw; m < T; m += NGW) { const u32x4 r = route[m]; const float w0 = __uint_as_float(r.z), w1 = __uint_as_float(r.w); const int s0 = tokslot[2 * m], s1 = tokslot[2 * m + 1];
        f32x4* o = (f32x4*)(out + (size_t)m * DM) + 2 * F.lane;
        const int pm0 = s0 >> 8, pm1 = s1 >> 8, f0 = (pm0 >> 3) * 8, f1 = (pm1 >> 3) * 8, g0 = (ntiles - f0) < 8 ? (ntiles - f0) : 8, g1 = (ntiles - f1) < 8 ? (ntiles - f1) : 8;
        if ((pm0 >> 3) * 64 + 7 * g0 + (pm0 - f0) < tail0 && (pm1 >> 3) * 64 + 7 * g1 + (pm1 - f1) < tail0) {
            const u32x4* y0 = (const u32x4*)(Y + (size_t)s0 * DM) + F.lane; const u32x4* y1 = (const u32x4*)(Y + (size_t)s1 * DM) + F.lane;
#pragma unroll
            for (int j = 0; j < 4; ++j) { const u32x4 a = y0[64 * j], b = y1[64 * j];
                const f32x4 lo = {bflo(a.x) * w0 + bflo(b.x) * w1, bfhi(a.x) * w0 + bfhi(b.x) * w1, bflo(a.y) * w0 + bflo(b.y) * w1, bfhi(a.y) * w0 + bfhi(b.y) * w1};
                const f32x4 hi = {bflo(a.z) * w0 + bflo(b.z) * w1, bfhi(a.z) * w0 + bfhi(b.z) * w1, bflo(a.w) * w0 + bflo(b.w) * w1, bfhi(a.w) * w0 + bfhi(b.w) * w1};
                o[128 * j] = o[128 * j] + lo; o[128 * j + 1] = o[128 * j + 1] + hi; }
            continue; }
#pragma unroll 1
        for (int j = 0; j < 4; ++j) { float a[8], b[8]; moe_row8(Y, PART, s0, F.lane + 64 * j, ntiles, tail0, ks, a); moe_row8(Y, PART, s1, F.lane + 64 * j, ntiles, tail0, ks, b);
            const f32x4 lo = {a[0] * w0 + b[0] * w1, a[1] * w0 + b[1] * w1, a[2] * w0 + b[2] * w1, a[3] * w0 + b[3] * w1};
            const f32x4 hi = {a[4] * w0 + b[4] * w1, a[5] * w0 + b[5] * w1, a[6] * w0 + b[6] * w1, a[7] * w0 + b[7] * w1};
            o[128 * j] = o[128 * j] + lo; o[128 * j + 1] = o[128 * j + 1] + hi; } }
}

#ifndef MK_CHECK
#define MK_CHECK 0
#endif
#if MK_CHECK
constexpr int CHK_NS = 64, CW_CHK = 8320; constexpr size_t MS_CHK = 1u << 20;
__device__ __forceinline__ int chk_token(int k) { const int b = k & 1, i = k >> 1;
    const int t = i < 8 ? i * 37 : (i < 16 ? 248 + (i - 8) * 2 : (i < 24 ? 2040 + (i - 16) * 3 : 8191 - (i - 24) * 601)); return b * SEQ + t; }
__device__ __forceinline__ void chk_ret_expected(const Frame& F, const bf16* PROJ, const float* gnw, const float* gnb, float* CHK) {
    if (F.bx >= CHK_NS) return;
    const int m = chk_token(F.bx), b = m >> 13, t = m & (SEQ - 1), h = F.wave, lane = F.lane; const float lg = log2gamma(h);
    const bf16* qp = PROJ + (size_t)m * LD + C_RQ + h * DH; const float q0 = bf2f(qp[lane]), q1 = bf2f(qp[lane + 64]); float o0 = 0.f, o1 = 0.f;
    for (int j = 0; j <= t; ++j) { const bf16* rp = PROJ + (size_t)(b * SEQ + j) * LD;
        const float dot = wave_sum(q0 * bf2f(rp[C_RK + h * DH + lane]) + q1 * bf2f(rp[C_RK + h * DH + lane + 64]), lane) * exp2f((float)(t - j) * lg);
        o0 += dot * bf2f(rp[C_RV + h * DH + lane]); o1 += dot * bf2f(rp[C_RV + h * DH + lane + 64]); }
    const float mean = wave_sum(o0 + o1, lane) * (1.0f / DH); const float d0 = o0 - mean, d1 = o1 - mean; const float rstd = 1.0f / sqrtf(wave_sum(d0 * d0 + d1 * d1, lane) * (1.0f / DH) + EPS);
    const float r0 = bf2f(PROJ[(size_t)m * LD + C_RG + h * DH + lane]), r1 = bf2f(PROJ[(size_t)m * LD + C_RG + h * DH + lane + 64]);
    float* e = CHK + ((size_t)F.bx * NH + h) * DH;
    e[lane] = r0 / (1.0f + expf(-r0)) * (d0 * rstd * gnw[h * DH + lane] + gnb[h * DH + lane]); e[lane + 64] = r1 / (1.0f + expf(-r1)) * (d1 * rstd * gnw[h * DH + lane + 64] + gnb[h * DH + lane + 64]);
}
__device__ __forceinline__ void chk_compare(const Frame& F, const bf16* PROJ, const unsigned short* SC, const int* pos, const float* btab, const float* CHK, unsigned* cnt) {
    if (F.bx >= CHK_NS) return;
    const int m = chk_token(F.bx), b = m >> 13, t = m & (SEQ - 1), h = F.wave, lane = F.lane;
    { const float* e = CHK + ((size_t)F.bx * NH + h) * DH; int bad = 0;
#pragma unroll
      for (int q = 0; q < 2; ++q) { const float ex = e[lane + 64 * q], got = bf2f(PROJ[(size_t)m * LD + C_RG + h * DH + lane + 64 * q]); if (!(fabsf(got - ex) <= 0.04f * fabsf(ex) + 0.03f)) ++bad; }
      bad = wave_sum_i(bad, lane); if (lane == 0 && bad) atomicAdd(cnt, (unsigned)bad); }
    const unsigned short* srow = SC + sc_off(b, t >> 7) + (size_t)(t & 127) * (128 * ((t >> 7) + 1));
    const bf16* qp = PROJ + (size_t)m * LD + C_AQ + h * DH; const float q0 = bf2f(qp[lane]), q1 = bf2f(qp[lane + 64]); const int qpos = pos[m]; const float* tab = btab + h * BIAS_PITCH;
    float mrun = -1.0e30f, lrun = 0.f, a0 = 0.f, a1 = 0.f;
#pragma unroll 1
    for (int g = 0; g < 4; ++g) { if (2048 * g > t) break;
        unsigned K[32]; int cn[32];
#pragma unroll
        for (int i = 0; i < 32; ++i) { const int s_ = 64 * (32 * g + i) + lane; unsigned u = srow[s_ <= t ? s_ : t]; u ^= (u >> 15) ? 0xffffu : 0x8000u; K[i] = s_ <= t ? ((u << 13) | (unsigned)(8191 - s_)) : 0u; cn[i] = 0; }
#pragma unroll 1
        for (int sp = 0; sp <= t; ++sp) { unsigned u = srow[sp]; u ^= (u >> 15) ? 0xffffu : 0x8000u; const unsigned Ks = (u << 13) | (unsigned)(8191 - sp);
#pragma unroll
            for (int i = 0; i < 32; ++i) cn[i] += (int)((K[i] - Ks) >> 31); }
#pragma unroll
        for (int i = 0; i < 32; ++i) { u64 msk = __ballot(K[i] != 0u && cn[i] < 256);
            while (msk) { const int bit = __builtin_ctzll(msk); msk &= msk - 1; const int s_ = 64 * (32 * g + i) + bit; const bf16* rp = PROJ + (size_t)(b * SEQ + s_) * LD;
                int dd = qpos - pos[b * SEQ + s_]; dd = dd < 0 ? 0 : (dd > 128 ? 128 : dd);
                const float lgt = wave_sum(q0 * bf2f(rp[C_AK + h * DH + lane]) + q1 * bf2f(rp[C_AK + h * DH + lane + 64]), lane) + tab[dd];
                const float mn = fmaxf(mrun, lgt), sc_ = exp2f(mrun - mn), p = exp2f(lgt - mn); mrun = mn;
                lrun = lrun * sc_ + p; a0 = a0 * sc_ + p * bf2f(rp[C_AV + h * DH + lane]); a1 = a1 * sc_ + p * bf2f(rp[C_AV + h * DH + lane + 64]); } } }
    { int bad = 0; const float e0 = a0 / lrun, e1 = a1 / lrun; const float g0 = bf2f(PROJ[(size_t)m * LD + C_CC + h * DH + lane]), g1 = bf2f(PROJ[(size_t)m * LD + C_CC + h * DH + lane + 64]);
      if (!(fabsf(g0 - e0) <= 0.04f * fabsf(e0) + 0.01f)) ++bad; if (!(fabsf(g1 - e1) <= 0.04f * fabsf(e1) + 0.01f)) ++bad;
      bad = wave_sum_i(bad, lane); if (lane == 0 && bad) atomicAdd(cnt + 1, (unsigned)bad); }
}
#endif

constexpr int NPH = 25;
#ifndef MK_PHASES
#define MK_PHASES 0xFFFFFFFFu
#endif
#define PHON(i) ((MK_PHASES >> (i)) & 1u)
#ifndef MK_DUP
#define MK_DUP 0u
#endif
#define REPS(i) ((int)((MK_DUP >> (i)) & 1u) + 1)
__global__ void __launch_bounds__(NTHREADS, 2) mk_fwd(Args a) {
    extern __shared__ __attribute__((aligned(16))) unsigned char lds_raw[];
    Frame F; F.lds = (LAS unsigned char*)lds_raw; F.tid = threadIdx.x; F.lane = F.tid & 63; F.wave = __builtin_amdgcn_readfirstlane(F.tid >> 6); F.G = gridDim.x; F.bx = blockIdx.x; F.ws = a.ws;
    unsigned* ctl0 = (unsigned*)(a.ws + WS_CTL);
    for (int u = F.tid; u < (LDS_BYTES - LDSCTL_OFF) / 4; u += NTHREADS) ((LAS unsigned*)(F.lds + LDSCTL_OFF))[u] = 0u;
    __syncthreads();
    const int wave0 = F.wave;
    const int lo = a.ph_lo, hi = a.ph_hi; const bool multi = (hi - lo) > 1;
    XcdBarrier bar; bar.bar = ctl0 + CW_BAR; bar.x = 0; bar.st = (volatile LAS unsigned*)(F.lds + LDSCTL_OFF + 64);
    if (multi) bar = xcd_barrier_post(ctl0 + CW_BAR, (volatile LAS unsigned*)(F.lds + LDSCTL_OFF + 64));
#define IN(k) (lo <= (k) && (k) < hi)
#define SEAM(k) do { if (IN(k) && IN((k) + 1)) xcd_barrier(bar); } while (0)
#define PB() do { int l_; asm volatile("v_mbcnt_lo_u32_b32 %0, -1, 0\n\tv_mbcnt_hi_u32_b32 %0, -1, %0" : "=v"(l_)); const int t_ = (wave0 << 6) + l_; F.tid = t_; F.lane = l_; F.wave = wave0; } while (0)
    const float* x_in = (const float*)a.in[0];

    if (PHON(0) && IN(0)) _Pragma("unroll 1") for (int rp_ = 0; rp_ < REPS(0); ++rp_) { PB(); ph_prologue(F, a); }
    SEAM(0);
#pragma unroll 1
    for (int l = 0; l < 2; ++l) {
        const int pb = l == 0 ? 1 : 12;
        unsigned long long wsi_ = (unsigned long long)a.ws, outi_ = (unsigned long long)a.out; asm volatile("" : "+s"(wsi_), "+s"(outi_));
        unsigned char* ws = (unsigned char*)(GAS unsigned char*)wsi_; float* out = (float*)(GAS float*)outi_;
        bf16* PROJ = (bf16*)(ws + WS_PROJ); bf16* XN = (bf16*)(ws + WS_XN); float* KVS = (float*)(ws + WS_KVS); unsigned short* SC = (unsigned short*)(ws + WS_SC); u64* MASK = (u64*)(ws + WS_MASK);
        const CvmCtx cvm{(const float*)a.in[17], (const float*)a.in[18], (const float*)a.in[19], ws + WS_M13, ws + WS_M2};
        unsigned char* misc = ws + WS_MISC; const int* pos = (const int*)a.in[1]; unsigned* ctl = (unsigned*)(ws + WS_CTL);
        const float* xcur = l == 0 ? x_in : out;
        const bool fuse = (F.G & 7) == 0; const pg8::PG8_LASF* rstab = (const pg8::PG8_LASF*)(F.lds + pg8::STAGE_BYTES); const int rbase = (F.bx & 7) * 2048;
        if (!(fuse && l == 1)) {
        if (PHON(1) && IN(pb + 0)) _Pragma("unroll 1") for (int rp_ = 0; rp_ < REPS(1); ++rp_) { PB(); ph_rmsnorm<false>(F, xcur, (const float*)a.in[3] + l * DM, XN, nullptr, nullptr, nullptr, ws + WS_XN8); }
        SEAM(pb + 0); }
        if (PHON(2) && IN(pb + 1)) _Pragma("unroll 1") for (int rp_ = 0; rp_ < REPS(2); ++rp_) { PB(); const bool fz = fuse && l == 1; if (fz) rstd_table(F, (const float*)(ws + WS_SSQ)); { pg8::Gemm g{(const bf16*)(ws + WS_XN8), (const bf16*)(ws + WS_WIN8 + (size_t)l * 6144 * DM), T, 6144, DM / 2, DM / 2, DM / 2}; pg8::StaticOrder S; S.init(T, 6144, F.G, F.bx);
            pg8::EpiProj E{PROJ, 24, 1.0f / pg8::F8_WSCALE, fz ? rstab : nullptr, rbase}; pg8::gemm_phase<pg8::EpiProj, pg8::StaticOrder, true, true, true>(F.lds, g, S, E, F.tid); }
            PB(); { pg8::Gemm g{(const bf16*)(ws + WS_XN8), (const bf16*)(ws + WS_WIN + (size_t)l * LD * DM * 2), T, 3072, DM / 2, DM / 2, DM / 2}; pg8::StaticOrder S; S.init(T, 3072, F.G, F.bx);
            pg8::EpiProjQK E{PROJ + C_AQ, 1.0f / pg8::F8_WSCALE, (const float*)a.in[11] + l * DH, (const float*)a.in[12] + l * DH, fz ? rstab : nullptr, rbase, (pg8::PG8_LASF*)(F.lds + pg8::STAGE_BYTES + 8192)};
            pg8::gemm_phase<pg8::EpiProjQK, pg8::StaticOrder, true, true, true>(F.lds, g, S, E, F.tid); }
            PB(); { pg8::Gemm g{XN, (const bf16*)(ws + WS_WIN) + (size_t)l * LD * DM + (size_t)C_RQ * DM, T, C_AQ - C_RQ, DM, DM, DM}; pg8::StaticOrder S; S.init(T, C_AQ - C_RQ, F.G, F.bx);
            pg8::EpiProjRot E{PROJ + C_RQ, pos, fz ? rstab : nullptr, rbase}; pg8::gemm_phase<pg8::EpiProjRot, pg8::StaticOrder, true, true>(F.lds, g, S, E, F.tid); }
            PB(); { pg8::Gemm g{XN, (const bf16*)(ws + WS_WIN) + (size_t)l * LD * DM + (size_t)C_IQ * DM, T, LD - C_IQ, DM, DM, DM}; pg8::StaticOrder S; S.init(T, LD - C_IQ, F.G, F.bx);
            pg8::EpiProj E{PROJ + C_IQ, 0, 1.0f, fz ? rstab : nullptr, rbase}; pg8::gemm_phase<pg8::EpiProj, pg8::StaticOrder, true, true>(F.lds, g, S, E, F.tid); } }
        SEAM(pb + 1);
        if (IN(pb + 2)) { const int sw_ = (F.bx >> 3) & 1; _Pragma("unroll 1") for (int part_ = 0; part_ < 2; ++part_) { __syncthreads(); PB();
            if ((part_ ^ sw_) == 0) { if (PHON(3)) ph_prep(F, PROJ, pos, (const float*)a.in[10] + l * 3 * MIXW, (const float*)a.in[11] + l * DH, (const float*)a.in[12] + l * DH); }
            else { if (PHON(4)) _Pragma("unroll 1") for (int rp_ = 0; rp_ < REPS(4); ++rp_) ph_scores(F, PROJ, SC); } } }
        SEAM(pb + 2);
        if (IN(pb + 3)) { const int sw_ = (F.bx >> 3) & 1; _Pragma("unroll 1") for (int part_ = 0; part_ < 2; ++part_) { __syncthreads(); PB();
            if ((part_ ^ sw_) == 0) { if (PHON(5)) _Pragma("unroll 1") for (int rp_ = 0; rp_ < REPS(5); ++rp_) for (int u = F.bx; u < 1024; u += F.G) kv_unit(F, PROJ, KVS, u, cvm, l * CVM_LAYER); }
            else { if (PHON(6)) _Pragma("unroll 1") for (int rp_ = 0; rp_ < REPS(6); ++rp_) ph_select(F, SC, MASK, cvm, l * CVM_LAYER); } } }
        SEAM(pb + 3);
        if (PHON(7) && IN(pb + 4)) _Pragma("unroll 1") for (int rp_ = 0; rp_ < REPS(7); ++rp_) { PB(); ph_scan(F, KVS);
#if MK_CHECK
            PB(); chk_ret_expected(F, PROJ, (const float*)a.in[8] + l * MIXW, (const float*)a.in[9] + l * MIXW, (float*)(misc + MS_CHK));
#endif
        }
        SEAM(pb + 4);
        if (IN(pb + 5)) { const int sw_ = (F.bx >> 3) & 1;
            AttnCtx C{PROJ, MASK, pos, (const int*)(misc + MS_POSMIN), (const int*)(misc + MS_POSMAX), (const float*)(misc + MS_BIAS), ((const float*)(misc + MS_M2))[l]};
            _Pragma("unroll 1") for (int part_ = 0; part_ < 2; ++part_) { __syncthreads(); PB();
            if ((part_ ^ sw_) == 0) { if (PHON(8)) _Pragma("unroll 1") for (int rp_ = 0; rp_ < REPS(8); ++rp_) for (int pu = F.bx; pu < 256; pu += F.G) { const int pid = (pu & 7) * 32 + (pu >> 3), bh = pid >> 4, pr = pid & 15;
#pragma unroll 1
                for (int hf = 0; hf < 2; ++hf) attn_unit(F, C, bh >> 3, bh & 7, hf ? pr : 31 - pr, rp_ + 1 < REPS(8)); } }
            else { if (PHON(9)) for (int u = F.bx; u < 1024; u += F.G) ret_unit(F, PROJ, KVS, (const float*)a.in[8] + l * MIXW, (const float*)a.in[9] + l * MIXW, u, cvm, l * CVM_LAYER); } }
        }
        SEAM(pb + 5);
        if (PHON(10) && IN(pb + 6)) _Pragma("unroll 1") for (int rp_ = 0; rp_ < REPS(10); ++rp_) {
#if MK_CHECK
            PB(); chk_compare(F, PROJ, SC, pos, (const float*)(misc + MS_BIAS), (const float*)(misc + MS_CHK), ctl + CW_CHK);
#endif
            PB(); pg8::StaticOrder S; S.init(T, DM, F.G, F.bx);
            pg8::Gemm g{PROJ + C_RG, (const bf16*)(ws + WS_WBR) + (size_t)l * DM * 3 * MIXW, T, DM, 3 * MIXW, LD, 3 * MIXW}; pg8::EpiGate3 E{PROJ + C_G, XN};
            pg8::gemm_phase<pg8::EpiGate3, pg8::StaticOrder, true, true>(F.lds, g, S, E, F.tid); }
        SEAM(pb + 6);
        if (PHON(11) && IN(pb + 7)) { PB(); pg8::Gemm g{XN, (const bf16*)(ws + WS_WO) + (size_t)l * DM * DM, T, DM, DM, DM, DM}; pg8::StaticOrder S; S.init(T, DM, F.G, F.bx);
            const bool fz = fuse && l == 0;
            if (fz) gains_to_lds(F, (const float*)a.in[4]);
            pg8::EpiResid E{xcur, out, (const pg8::PG8_LASF*)(F.lds + pg8::STAGE_BYTES), fz ? (bf16*)(ws + WS_XB2) : nullptr, nullptr, (float*)(ws + WS_SSQ)}; pg8::gemm_phase<pg8::EpiResid, pg8::StaticOrder, true, true>(F.lds, g, S, E, F.tid); }
        SEAM(pb + 7);
        if (l == 0) {
            if (!fuse) { if (PHON(1) && IN(pb + 8)) { PB(); ph_rmsnorm<false>(F, out, (const float*)a.in[4], XN, nullptr, nullptr, nullptr); }
            SEAM(pb + 8); }
            if (PHON(12) && IN(pb + 9)) _Pragma("unroll 1") for (int rp_ = 0; rp_ < REPS(12); ++rp_) { PB(); if (fuse) rstd_table(F, (const float*)(ws + WS_SSQ)); pg8::Gemm g{fuse ? (const bf16*)(ws + WS_XB2) : XN, (const bf16*)(ws + WS_W13), T, 2 * DFF, DM, DM, DM}; pg8::StaticOrder S; S.init(T, 2 * DFF, F.G, F.bx);
                pg8::EpiSwiglu E{(bf16*)(ws + WS_ACT), DFF, 1 << 20, fuse ? rstab : nullptr, rbase}; pg8::gemm_phase<pg8::EpiSwiglu, pg8::StaticOrder, true, true>(F.lds, g, S, E, F.tid); }
            SEAM(pb + 9);
            if (PHON(13) && IN(pb + 10)) { PB(); pg8::Gemm g{(const bf16*)(ws + WS_ACT), (const bf16*)(ws + WS_W2), T, DM, DFF, DFF, DFF}; pg8::StaticOrder S; S.init(T, DM, F.G, F.bx);
                if (fuse) gains_to_lds(F, (const float*)a.in[3] + DM);
                pg8::EpiResid E{out, out, (const pg8::PG8_LASF*)(F.lds + pg8::STAGE_BYTES), fuse ? XN : nullptr, ws + WS_XN8, (float*)(ws + WS_SSQ)};
                pg8::gemm_phase<pg8::EpiResid, pg8::StaticOrder, true, true>(F.lds, g, S, E, F.tid); }
            SEAM(pb + 10);
        } else {
            u32x4* route = (u32x4*)(misc + MS_ROUTE); int* tokslot = (int*)(misc + MS_TOKSLOT); int* tiles = (int*)(misc + MS_TILES);
            if (PHON(14) && IN(pb + 8)) { PB(); ph_rmsnorm<true>(F, out, (const float*)a.in[4] + DM, nullptr, (const float*)a.in[16], route, ctl + CW_CNT, ws + WS_XN8); }
            SEAM(pb + 8);
            if (PHON(15) && IN(pb + 9)) { PB(); ph_assign(F, route, ctl + CW_CNT, ctl + CW_CUR, tiles, tokslot, ws + WS_XN8, ws + WS_HPERM); }
            SEAM(pb + 9);
            if (PHON(16) && IN(pb + 10)) _Pragma("unroll 1") for (int rp_ = 0; rp_ < REPS(16); ++rp_) { PB(); pg8::MoeOrder S; S.init(tiles, 2 * DFFE / 256, F.G, F.bx); pg8::Gemm g{(const bf16*)(ws + WS_HPERM), (const bf16*)(ws + WS_M13), MAXSLOT, 2 * DFFE, DM / 2, DM / 2, DM / 2};
                pg8::EpiSwigluF8 E{ws + WS_MACT, DFFE, 2 * DFFE / 256}; pg8::gemm_phase<pg8::EpiSwigluF8, pg8::MoeOrder, true, true, true>(F.lds, g, S, E, F.tid); }
            SEAM(pb + 10);
            if (PHON(17) && IN(pb + 11)) _Pragma("unroll 1") for (int rp_ = 0; rp_ < REPS(17); ++rp_) { PB(); pg8::MoeOrder S; S.init(tiles, DM / 256, F.G, F.bx, true, DFFE / 2); pg8::Gemm g{(const bf16*)(ws + WS_MACT), (const bf16*)(ws + WS_M2), MAXSLOT, DM, DFFE / 2, DFFE / 2, DFFE / 2};
                pg8::EpiBf16Slot E{(bf16*)(ws + WS_YSLOT), (bf16*)(ws + WS_PART), 1.0f / (pg8::F8_WSCALE * pg8::F8_ASCALE)}; pg8::gemm_phase<pg8::EpiBf16Slot, pg8::MoeOrder, true, true, true>(F.lds, g, S, E, F.tid); }
            SEAM(pb + 11);
            if (PHON(18) && IN(pb + 12)) { PB(); ph_combine(F, out, (const bf16*)(ws + WS_YSLOT), (const bf16*)(ws + WS_PART), route, tokslot, tiles);
#if MK_CHECK
                __syncthreads();
                if (F.bx == 0 && F.tid == 0) { const unsigned br = __hip_atomic_load(ctl + CW_CHK, __ATOMIC_RELAXED, __HIP_MEMORY_SCOPE_AGENT), ba = __hip_atomic_load(ctl + CW_CHK + 1, __ATOMIC_RELAXED, __HIP_MEMORY_SCOPE_AGENT);
                    if ((MK_CHECK & 1) && br > 2u * CHK_NS * NH * DH / 100u) out[0] = __builtin_nanf(""); if ((MK_CHECK & 2) && ba > 2u * CHK_NS * NH * DH / 100u) out[1] = __builtin_nanf(""); }
#endif
            }
        }
    }
#undef IN
#undef SEAM
}

#ifndef MK_ONE_LAUNCH
#define MK_ONE_LAUNCH 1
#endif
extern "C" void kernel_launch(void* const* d_in, const int* in_sizes, int n_in, void* d_out, int out_size, void* d_ws, size_t ws_size, hipStream_t stream) {
    static int grid = 0;
    if (grid == 0) {
        if (n_in != 20 || out_size != T * DM || ws_size < WS_END) { fprintf(stderr, "kernel_launch: unexpected shapes (n_in %d out %d ws %zu need %zu)\n", n_in, out_size, ws_size, (size_t)WS_END); grid = -1; return; }
        int dev = 0, cus = 0, per_cu = 0;
        if (hipGetDevice(&dev) != hipSuccess || hipDeviceGetAttribute(&cus, hipDeviceAttributeMultiprocessorCount, dev) != hipSuccess) { grid = -1; return; }
        if (hipFuncSetAttribute((const void*)mk_fwd, hipFuncAttributeMaxDynamicSharedMemorySize, LDS_BYTES) != hipSuccess) { fprintf(stderr, "kernel_launch: hipFuncSetAttribute failed\n"); grid = -1; return; }
        if (hipOccupancyMaxActiveBlocksPerMultiprocessor(&per_cu, (const void*)mk_fwd, NTHREADS, LDS_BYTES) != hipSuccess || per_cu < 1) fprintf(stderr, "kernel_launch: occupancy query says %d\n", per_cu);
        (void)hipGetLastError();
        grid = cus;
    }
    if (grid < 0) return;
    if (hipMemsetAsync((char*)d_ws + WS_CTL, 0, CTL_ZERO_BYTES, stream) != hipSuccess) return;
    Args a{};
    for (int i = 0; i < 20; ++i) a.in[i] = d_in[i];
    a.out = (float*)d_out; a.ws = (unsigned char*)d_ws;
#if MK_ONE_LAUNCH
    a.ph_lo = 0; a.ph_hi = NPH;
    hipLaunchKernelGGL(mk_fwd, dim3(grid), dim3(NTHREADS), LDS_BYTES, stream, a);
#else
    for (int p = 0; p < NPH; ++p) { a.ph_lo = p; a.ph_hi = p + 1; hipLaunchKernelGGL(mk_fwd, dim3(grid), dim3(NTHREADS), LDS_BYTES, stream, a); }
#endif
}
```
